# Optimizing an MI355X kernel written in HIP

```python
import math
import jax, jax.numpy as jnp
from jax import lax
import numpy as np

D_MODEL = 1024
BATCH = 8
SEQ = 2048
DEPTH = 2

CHUNK = 64
N_MEM = 256
EPS = 1e-6
N_SUBLAYER_NORMS = 6

GDN_HEADS = 4
GDN_DK = 128
GDN_DV = 128
GDN_QK = GDN_HEADS * GDN_DK
GDN_VW = GDN_HEADS * GDN_DV
GDN_QKV = 2 * GDN_QK + GDN_VW
CONV_W = 4

MLA_HEADS = 4
MLA_Q_RANK = 256
MLA_KV_RANK = 256
MLA_NOPE = 128
MLA_ROPE = 64
MLA_V = 128
MLA_VW = MLA_HEADS * MLA_V
MLA_SCALE = (MLA_NOPE + MLA_ROPE) ** -0.5
ROPE_BASE = 10000.0
Q_BLOCK = 128

E_SECTIONS = (GDN_QKV, GDN_VW, GDN_HEADS, GDN_HEADS, MLA_Q_RANK, MLA_KV_RANK, MLA_ROPE)
E_IN = GDN_QKV + GDN_VW + 2 * GDN_HEADS + MLA_Q_RANK + MLA_KV_RANK + MLA_ROPE
E_MIX = GDN_VW + MLA_VW

LRU_WIDTH = D_MODEL
LRU_BLOCKS = 4
LRU_BW = LRU_WIDTH // LRU_BLOCKS
LRU_C = 8.0

XA_HEADS = 4
XA_HD = D_MODEL // XA_HEADS

D_FF = ((8 * D_MODEL + 3 * 256 - 1) // (3 * 256)) * 256

N_EVEN = (DEPTH + 1) // 2
N_ODD = DEPTH // 2

kernel_name = "hybrid_gdn_mla_rglru_streaming_block"


def rmsnorm(x, g):
    xf = x.astype(jnp.float32)
    y = xf * lax.rsqrt(jnp.mean(xf * xf, axis=-1, keepdims=True) + EPS)
    return (y * g.astype(jnp.float32)).astype(x.dtype)


def l2norm(x):
    return x * lax.rsqrt(jnp.sum(x * x, axis=-1, keepdims=True) + EPS)


def causal_conv(x, w):
    c = x.shape[-1]
    return lax.conv_general_dilated(
        x, w[:, None, :].astype(x.dtype), window_strides=(1,),
        padding=[(w.shape[0] - 1, 0)], dimension_numbers=("NWC", "WIO", "NWC"),
        feature_group_count=c)


def rope_tables(positions):
    inv_freq = ROPE_BASE ** (-jnp.arange(0, MLA_ROPE, 2, dtype=jnp.float32) / MLA_ROPE)
    ang = positions.astype(jnp.float32)[..., None] * inv_freq
    return jnp.cos(ang), jnp.sin(ang)


def apply_rope(x, cos, sin):
    x1, x2 = jnp.split(x, 2, axis=-1)
    cos = cos.astype(x.dtype)
    sin = sin.astype(x.dtype)
    return jnp.concatenate([x1 * cos - x2 * sin, x1 * sin + x2 * cos], axis=-1)


def gated_delta_rule(q, k, v, g, beta):
    b_, t_, h_, dk = q.shape
    dv = v.shape[-1]
    n = t_ // CHUNK

    def to_chunks(a):
        a = jnp.moveaxis(a, 2, 1)
        return a.reshape(b_, h_, n, CHUNK, *a.shape[3:])

    q, k, v, g, beta = map(to_chunks, (q, k, v, g, beta))
    gc = jnp.cumsum(g, axis=-1)
    idx = jnp.arange(CHUNK)
    causal = idx[:, None] >= idx[None, :]
    strict = idx[:, None] > idx[None, :]
    decay = jnp.exp(jnp.where(causal, gc[..., :, None] - gc[..., None, :], -jnp.inf))
    kb = k * beta[..., None]
    vb = v * beta[..., None]
    lower = jnp.where(strict, jnp.einsum("bhncd,bhnsd->bhncs", kb, k) * decay, 0.0)
    rhs = jnp.concatenate([vb, kb * jnp.exp(gc)[..., None]], axis=-1)
    sol = lax.linalg.triangular_solve(lower, rhs, left_side=True, lower=True,
                                      unit_diagonal=True)
    u, w = sol[..., :dv], sol[..., dv:]
    a_qk = jnp.where(causal, jnp.einsum("bhncd,bhnsd->bhncs", q, k) * decay, 0.0)

    def step(state, xs):
        q_i, k_i, u_i, w_i, gc_i, a_i = xs
        v_new = u_i - jnp.einsum("bhck,bhkv->bhcv", w_i, state)
        o_i = (jnp.einsum("bhck,bhkv->bhcv", q_i * jnp.exp(gc_i)[..., None], state)
               + jnp.einsum("bhcs,bhsv->bhcv", a_i, v_new))
        g_last = gc_i[..., -1]
        k_dec = k_i * jnp.exp(g_last[..., None] - gc_i)[..., None]
        state = state * jnp.exp(g_last)[..., None, None] + jnp.einsum(
            "bhck,bhcv->bhkv", k_dec, v_new)
        return state, o_i

    xs = tuple(jnp.moveaxis(a, 2, 0) for a in (q, k, u, w, gc, a_qk))
    s0 = jnp.zeros((b_, h_, dk, dv), jnp.float32)
    _, o = lax.scan(step, s0, xs)
    o = jnp.moveaxis(o, 0, 2).reshape(b_, h_, t_, dv)
    return jnp.moveaxis(o, 1, 2)


def mla_attention(q_nope, q_pe, k_nope, k_pe, v):
    b_, t_, h_, _ = q_nope.shape
    nqb = t_ // Q_BLOCK
    key_chunk = jnp.arange(t_) // CHUNK

    def block(args):
        i, qn, qp = args
        s = (jnp.einsum("bqhd,bkhd->bhqk", qn, k_nope)
             + jnp.einsum("bqhd,bkd->bhqk", qp, k_pe))
        s = s.astype(jnp.float32) * MLA_SCALE
        q_chunk = (i * Q_BLOCK + jnp.arange(Q_BLOCK)) // CHUNK
        s = jnp.where(key_chunk[None, :] <= q_chunk[:, None], s, -jnp.inf)
        p = jax.nn.softmax(s, axis=-1).astype(v.dtype)
        return jnp.einsum("bhqk,bkhd->bqhd", p, v)

    def to_blocks(a):
        return jnp.moveaxis(a.reshape(b_, nqb, Q_BLOCK, *a.shape[2:]), 1, 0)

    out = lax.map(block, (jnp.arange(nqb), to_blocks(q_nope), to_blocks(q_pe)))
    return jnp.moveaxis(out, 0, 1).reshape(b_, t_, h_, MLA_V)


def gdn_mla_mixer(h, cos, sin, w_in, conv_w, a_log, dt_bias, o_norm,
                  q_norm, kv_norm, w_uq, w_ukv, w_out):
    b_, t_, _ = h.shape
    f32 = jnp.float32
    cuts = np.cumsum(E_SECTIONS)[:-1].tolist()
    qkv, z, a, b, c_q, c_kv, k_rope = jnp.split(h @ w_in, cuts, axis=-1)

    qkv = jax.nn.silu(causal_conv(qkv, conv_w)).astype(f32)
    q, k, v = jnp.split(qkv, [GDN_QK, 2 * GDN_QK], axis=-1)
    q = l2norm(q.reshape(b_, t_, GDN_HEADS, GDN_DK)) * (GDN_DK ** -0.5)
    k = l2norm(k.reshape(b_, t_, GDN_HEADS, GDN_DK))
    v = v.reshape(b_, t_, GDN_HEADS, GDN_DV)
    beta = jax.nn.sigmoid(b.astype(f32))
    g = -jnp.exp(a_log.astype(f32)) * jax.nn.softplus(a.astype(f32) + dt_bias.astype(f32))
    o = gated_delta_rule(q, k, v, g, beta)
    o = rmsnorm(o, o_norm) * jax.nn.silu(z.reshape(b_, t_, GDN_HEADS, GDN_DV).astype(f32))
    out_a = o.reshape(b_, t_, GDN_VW).astype(h.dtype)

    qf = (rmsnorm(c_q, q_norm) @ w_uq).reshape(b_, t_, MLA_HEADS, MLA_NOPE + MLA_ROPE)
    q_nope, q_pe = qf[..., :MLA_NOPE], qf[..., MLA_NOPE:]
    kvf = (rmsnorm(c_kv, kv_norm) @ w_ukv).reshape(b_, t_, MLA_HEADS, MLA_NOPE + MLA_V)
    k_nope, v_b = kvf[..., :MLA_NOPE], kvf[..., MLA_NOPE:]
    q_pe = apply_rope(q_pe, cos[:, :, None, :], sin[:, :, None, :])
    k_pe = apply_rope(k_rope, cos, sin)
    out_b = mla_attention(q_nope, q_pe, k_nope, k_pe, v_b).reshape(b_, t_, MLA_VW)

    return jnp.concatenate([out_a, out_b], axis=-1) @ w_out


def _lru_combine(c1, c2):
    a1, b1 = c1
    a2, b2 = c2
    return a1 * a2, a2 * b1 + b2


def rglru_mixer(h, w_in, conv_w, conv_b, gate_a_w, gate_a_b, gate_x_w, gate_x_b,
                a_param, w_out):
    b_, t_, _ = h.shape
    f32 = jnp.float32
    xb, yb = jnp.split(h @ w_in, 2, axis=-1)
    gate = jax.nn.gelu(yb)
    xb = causal_conv(xb, conv_w) + conv_b
    xr = xb.reshape(b_, t_, LRU_BLOCKS, LRU_BW)
    r = jax.nn.sigmoid((jnp.einsum("btnd,nde->btne", xr, gate_a_w)
                        .reshape(b_, t_, LRU_WIDTH) + gate_a_b).astype(f32))
    i = jax.nn.sigmoid((jnp.einsum("btnd,nde->btne", xr, gate_x_w)
                        .reshape(b_, t_, LRU_WIDTH) + gate_x_b).astype(f32))
    log_a = -LRU_C * r * jax.nn.softplus(-a_param.astype(f32))
    a = jnp.exp(log_a)
    u = jnp.sqrt(-jnp.expm1(2.0 * log_a)) * (i * xb.astype(f32))
    _, hs = lax.associative_scan(_lru_combine, (a, u), axis=1)
    return (hs.astype(h.dtype) * gate) @ w_out


def memory_cross_attention(h, mem_n, wq, wkv, wo):
    b_, t_, _ = h.shape
    q = (h @ wq).reshape(b_, t_, XA_HEADS, XA_HD)
    k, v = jnp.split(mem_n @ wkv, 2, axis=-1)
    k = k.reshape(b_, N_MEM, XA_HEADS, XA_HD)
    v = v.reshape(b_, N_MEM, XA_HEADS, XA_HD)
    s = jnp.einsum("bthd,bmhd->bhtm", q, k).astype(jnp.float32) * (XA_HD ** -0.5)
    p = jax.nn.softmax(s, axis=-1).astype(v.dtype)
    o = jnp.einsum("bhtm,bmhd->bthd", p, v).reshape(b_, t_, D_MODEL)
    return o @ wo


def swiglu(h, w_in, w_out):
    gate, up = jnp.split(h @ w_in, 2, axis=-1)
    return (jax.nn.silu(gate) * up) @ w_out


def setup_inputs(seed: int = 0) -> dict:
    key = jax.random.key(seed)
    ks = list(jax.random.split(key, 40))
    f32 = jnp.float32

    def nrm(shape, fan_in):
        return jax.random.normal(ks.pop(), shape, f32) * (fan_in ** -0.5)

    def gain(shape):
        return 1.0 + 0.05 * jax.random.normal(ks.pop(), shape, f32)

    def small(shape):
        return 0.01 * jax.random.normal(ks.pop(), shape, f32)

    x = jax.random.normal(ks.pop(), (BATCH, SEQ, D_MODEL), f32)
    mem = jax.random.normal(ks.pop(), (BATCH, N_MEM, D_MODEL), f32)
    offset = jax.random.randint(ks.pop(), (BATCH, 1), 0, 64, dtype=jnp.int32) * CHUNK
    positions = (offset + jnp.arange(SEQ, dtype=jnp.int32)[None, :]).astype(jnp.int32)

    e_a_log = jnp.log(jax.random.uniform(ks.pop(), (N_EVEN, GDN_HEADS), f32, 1.0, 16.0))
    dt = jnp.exp(jax.random.uniform(ks.pop(), (N_EVEN, GDN_HEADS), f32,
                                    math.log(1e-3), math.log(1e-1)))
    e_dt_bias = dt + jnp.log(-jnp.expm1(-dt))
    a0 = jax.random.uniform(ks.pop(), (N_ODD, LRU_WIDTH), f32, 0.9, 0.999)
    o_a_param = jnp.log(a0) - jnp.log1p(-a0)

    return {
        "x": x,
        "mem": mem,
        "positions": positions,
        "norm_gains": gain((DEPTH, N_SUBLAYER_NORMS, D_MODEL)),
        "mem_norm": gain((D_MODEL,)),
        "e_w_in": nrm((N_EVEN, D_MODEL, E_IN), D_MODEL),
        "e_conv_w": nrm((N_EVEN, CONV_W, GDN_QKV), CONV_W),
        "e_a_log": e_a_log,
        "e_dt_bias": e_dt_bias,
        "e_o_norm": gain((N_EVEN, GDN_DV)),
        "e_q_norm": gain((N_EVEN, MLA_Q_RANK)),
        "e_kv_norm": gain((N_EVEN, MLA_KV_RANK)),
        "e_w_uq": nrm((N_EVEN, MLA_Q_RANK, MLA_HEADS * (MLA_NOPE + MLA_ROPE)), MLA_Q_RANK),
        "e_w_ukv": nrm((N_EVEN, MLA_KV_RANK, MLA_HEADS * (MLA_NOPE + MLA_V)), MLA_KV_RANK),
        "e_w_out": nrm((N_EVEN, E_MIX, D_MODEL), E_MIX),
        "o_w_in": nrm((N_ODD, D_MODEL, 2 * LRU_WIDTH), D_MODEL),
        "o_conv_w": nrm((N_ODD, CONV_W, LRU_WIDTH), CONV_W),
        "o_conv_b": small((N_ODD, LRU_WIDTH)),
        "o_gate_a_w": nrm((N_ODD, LRU_BLOCKS, LRU_BW, LRU_BW), LRU_BW),
        "o_gate_a_b": small((N_ODD, LRU_WIDTH)),
        "o_gate_x_w": nrm((N_ODD, LRU_BLOCKS, LRU_BW, LRU_BW), LRU_BW),
        "o_gate_x_b": small((N_ODD, LRU_WIDTH)),
        "o_a_param": o_a_param,
        "o_w_out": nrm((N_ODD, LRU_WIDTH, D_MODEL), LRU_WIDTH),
        "xa_wq": nrm((DEPTH, D_MODEL, D_MODEL), D_MODEL),
        "xa_wkv": nrm((DEPTH, D_MODEL, 2 * D_MODEL), D_MODEL),
        "xa_wo": nrm((DEPTH, D_MODEL, D_MODEL), D_MODEL),
        "ffn_w_in": nrm((DEPTH, D_MODEL, 2 * D_FF), D_MODEL),
        "ffn_w_out": nrm((DEPTH, D_FF, D_MODEL), D_FF),
    }


def reference(x, mem, positions, norm_gains, mem_norm,
              e_w_in, e_conv_w, e_a_log, e_dt_bias, e_o_norm, e_q_norm, e_kv_norm,
              e_w_uq, e_w_ukv, e_w_out,
              o_w_in, o_conv_w, o_conv_b, o_gate_a_w, o_gate_a_b, o_gate_x_w, o_gate_x_b,
              o_a_param, o_w_out,
              xa_wq, xa_wkv, xa_wo, ffn_w_in, ffn_w_out):
    cos, sin = rope_tables(positions)
    mem_n = rmsnorm(mem, mem_norm)
    for layer in range(DEPTH):
        g = norm_gains[layer]
        h = rmsnorm(x, g[0])
        if layer % 2 == 0:
            e = layer // 2
            y = gdn_mla_mixer(h, cos, sin, e_w_in[e], e_conv_w[e], e_a_log[e], e_dt_bias[e],
                              e_o_norm[e], e_q_norm[e], e_kv_norm[e], e_w_uq[e], e_w_ukv[e],
                              e_w_out[e])
        else:
            o = layer // 2
            y = rglru_mixer(h, o_w_in[o], o_conv_w[o], o_conv_b[o], o_gate_a_w[o],
                            o_gate_a_b[o], o_gate_x_w[o], o_gate_x_b[o], o_a_param[o],
                            o_w_out[o])
        x = x + rmsnorm(y, g[1])
        h = rmsnorm(x, g[2])
        x = x + rmsnorm(memory_cross_attention(h, mem_n, xa_wq[layer], xa_wkv[layer],
                                               xa_wo[layer]), g[3])
        h = rmsnorm(x, g[4])
        x = x + rmsnorm(swiglu(h, ffn_w_in[layer], ffn_w_out[layer]), g[5])
    return x
```

```cpp
#include <hip/hip_runtime.h>
#include <stdint.h>
#include <cstdio>

typedef unsigned short bf16_t;

constexpr int B_ = 8, T_ = 2048, D_ = 1024, M_ = B_ * T_;
constexpr int NMEM = 256, MM_ = B_ * NMEM;
constexpr int DFF = 2816;
constexpr int EIN = 2632;
constexpr float EPS = 1e-6f;

constexpr size_t MiB = 1u << 20;
constexpr size_t WS_CTL = 0;
constexpr size_t WS_WT = 1 * MiB;
constexpr size_t WS_KVMEM = 66 * MiB;
constexpr size_t WS_MEMN = 82 * MiB;
constexpr size_t WS_ROPEC = 86 * MiB;
constexpr size_t WS_ROPES = 88 * MiB;
constexpr size_t WS_ABUF = 90 * MiB;
constexpr size_t WS_SSQ = 90 * MiB + 512 * 1024;
constexpr size_t WS_KPE = 91 * MiB;
constexpr size_t WS_EGC = 93 * MiB;
constexpr size_t WS_EDEC = 93 * MiB + 256 * 1024;
constexpr size_t WS_EGL = 93 * MiB + 512 * 1024;
constexpr size_t WS_AGG = 94 * MiB;
constexpr size_t WS_H = 96 * MiB;
constexpr size_t WS_Y = 128 * MiB;
constexpr size_t WS_QK = 160 * MiB;
constexpr size_t WS_Z = 192 * MiB;
constexpr size_t WS_G = 208 * MiB;
constexpr size_t WS_U = 224 * MiB;
constexpr size_t WS_END = 256 * MiB;

__device__ __forceinline__ float bf2f(bf16_t v) { return __uint_as_float((unsigned)v << 16); }
__device__ __forceinline__ bf16_t f2bf(float f) { unsigned u = __float_as_uint(f); return (bf16_t)((u + 0x7fffu + ((u >> 16) & 1u)) >> 16); }
__device__ __forceinline__ float sigmoidf_(float x) { return 1.f / (1.f + __expf(-x)); }
__device__ __forceinline__ float softplusf_(float x) { return fmaxf(x, 0.f) + log1pf(__expf(-fabsf(x))); }
__device__ __forceinline__ float siluf_(float x) { return x * sigmoidf_(x); }
__device__ __forceinline__ float gelu_tanhf_(float x) { const float u = 0.7978845608028654f * (x + 0.044715f * x * x * x); return 0.5f * x * (1.f + tanhf(u)); }
__device__ __forceinline__ float wave_sum(float v) {
#pragma unroll
    for (int o = 1; o < 64; o <<= 1) v += __shfl_xor(v, o);
    return v;
}
__host__ __device__ __forceinline__ int rope_perm(int i, int half) { return (i >> 2) * 8 + half * 4 + (i & 3); }

__global__ void nk_rmsnorm(const float* __restrict__ x, const float* __restrict__ g, bf16_t* __restrict__ out, int rows) {
    const int row = blockIdx.x * 4 + (threadIdx.x >> 6), lane = threadIdx.x & 63;
    if (row >= rows) return;
    const float4* xr = (const float4*)(x + (size_t)row * D_);
    float4 v[4]; float s = 0.f;
#pragma unroll
    for (int j = 0; j < 4; ++j) { v[j] = xr[lane + 64 * j]; s += v[j].x * v[j].x + v[j].y * v[j].y + v[j].z * v[j].z + v[j].w * v[j].w; }
    const float r = rsqrtf(wave_sum(s) * (1.f / D_) + EPS);
#pragma unroll
    for (int j = 0; j < 4; ++j) { const int c = (lane + 64 * j) * 4; const float4 gg = *(const float4*)(g + c);
        bf16_t* o = out + (size_t)row * D_ + c; o[0] = f2bf(v[j].x * r * gg.x); o[1] = f2bf(v[j].y * r * gg.y); o[2] = f2bf(v[j].z * r * gg.z); o[3] = f2bf(v[j].w * r * gg.w); }
}
__global__ void nk_ropetab(const int* __restrict__ pos, float* __restrict__ ct, float* __restrict__ st) {
    const int idx = blockIdx.x * 256 + threadIdx.x; if (idx >= M_ * 32) return;
    const int m = idx >> 5, i = idx & 31;
    const float inv = powf(10000.f, -(float)(2 * i) / 64.f);
    const float ang = (float)pos[m] * inv; float s, c; sincosf(ang, &s, &c); ct[idx] = c; st[idx] = s;
}
__global__ void nk_rowwise(const bf16_t* __restrict__ y, const float* xin, float* xout, const float* __restrict__ g1, const float* __restrict__ g2, bf16_t* __restrict__ h) {
    const int row = blockIdx.x * 4 + (threadIdx.x >> 6), lane = threadIdx.x & 63;
    float yv[16], xv[16]; float s = 0.f;
#pragma unroll
    for (int j = 0; j < 4; ++j) { const int c = (lane + 64 * j) * 4;
#pragma unroll
        for (int e = 0; e < 4; ++e) { yv[j * 4 + e] = bf2f(y[(size_t)row * D_ + c + e]); s += yv[j * 4 + e] * yv[j * 4 + e]; } }
    const float r1 = rsqrtf(wave_sum(s) * (1.f / D_) + EPS); float s2 = 0.f;
#pragma unroll
    for (int j = 0; j < 4; ++j) { const int c = (lane + 64 * j) * 4;
#pragma unroll
        for (int e = 0; e < 4; ++e) { const float xn = xin[(size_t)row * D_ + c + e] + yv[j * 4 + e] * r1 * g1[c + e]; xv[j * 4 + e] = xn; s2 += xn * xn; xout[(size_t)row * D_ + c + e] = xn; } }
    if (h) { const float r2 = rsqrtf(wave_sum(s2) * (1.f / D_) + EPS);
#pragma unroll
        for (int j = 0; j < 4; ++j) { const int c = (lane + 64 * j) * 4;
#pragma unroll
            for (int e = 0; e < 4; ++e) h[(size_t)row * D_ + c + e] = f2bf(xv[j * 4 + e] * r2 * g2[c + e]); } }
}

template <bool DUAL, class Epi>
__global__ void __launch_bounds__(256) nk_gemm(const bf16_t* __restrict__ A, int lda, const float* __restrict__ W, const float* __restrict__ W2, int ldw, int N, int K, const float* __restrict__ ks, Epi epi) {
    constexpr int R = DUAL ? 16 : 32;
    __shared__ float As[32][36];
    const int tid = threadIdx.x, n = blockIdx.x * 256 + tid, m0 = blockIdx.y * R;
    const int nn = n < N ? n : N - 1;
    float acc[R], acc2[R];
#pragma unroll
    for (int r = 0; r < R; ++r) { acc[r] = 0.f; acc2[r] = 0.f; }
    for (int k0 = 0; k0 < K; k0 += 32) {
        __syncthreads();
#pragma unroll
        for (int i = 0; i < R / 8; ++i) { const int e = tid + 256 * i, r = e >> 5, kk = e & 31; float a = bf2f(A[(size_t)(m0 + r) * lda + k0 + kk]); if (ks) a *= ks[k0 + kk]; As[r][kk] = a; }
        __syncthreads();
#pragma unroll 1
        for (int k4 = 0; k4 < 8; ++k4) {
            float w[4], w2[4];
#pragma unroll
            for (int e = 0; e < 4; ++e) { w[e] = W[(size_t)(k0 + k4 * 4 + e) * ldw + nn]; w2[e] = DUAL ? W2[(size_t)(k0 + k4 * 4 + e) * ldw + nn] : 0.f; }
#pragma unroll
            for (int r = 0; r < R; ++r) { const float4 a = *(const float4*)&As[r][k4 * 4];
                acc[r] += a.x * w[0] + a.y * w[1] + a.z * w[2] + a.w * w[3];
                if (DUAL) acc2[r] += a.x * w2[0] + a.y * w2[1] + a.z * w2[2] + a.w * w2[3]; }
        }
    }
    if (n < N) {
#pragma unroll
        for (int r = 0; r < R; ++r) epi(m0 + r, n, acc[r], acc2[r]);
    }
}
struct EpiBf16N { bf16_t* O; int ldo, pad; __device__ void operator()(int m, int n, float v, float) const { O[(size_t)m * ldo + n] = f2bf(v); } };
struct EpiEinN { bf16_t *qk, *vb, *zb, *cqkv, *kpe; float* ab;
    __device__ void operator()(int m, int n, float v, float) const {
        if (n < 1024) qk[(size_t)m * 1024 + n] = f2bf(v);
        else if (n < 1536) vb[(size_t)m * 512 + n - 1024] = f2bf(v);
        else if (n < 2048) zb[(size_t)m * 512 + n - 1536] = f2bf(v);
        else if (n < 2056) ab[(size_t)m * 8 + n - 2048] = v;
        else if (n < 2568) cqkv[(size_t)m * 512 + n - 2056] = f2bf(v);
        else kpe[(size_t)m * 64 + n - 2568] = f2bf(v);
    } };
__global__ void nk_rope_inplace(bf16_t* __restrict__ buf, int ld, int nheads, int hstride, int off, const float* __restrict__ ct, const float* __restrict__ st) {
    const int idx = blockIdx.x * 256 + threadIdx.x; if (idx >= M_ * nheads) return;
    const int m = idx / nheads, h = idx % nheads;
    bf16_t* p = buf + (size_t)m * ld + h * hstride + off;
    float x[64];
#pragma unroll
    for (int i = 0; i < 64; ++i) x[i] = bf2f(p[i]);
#pragma unroll
    for (int i = 0; i < 32; ++i) { const float c = ct[m * 32 + i], s = st[m * 32 + i];
        p[rope_perm(i, 0)] = f2bf(x[i] * c - x[32 + i] * s); p[rope_perm(i, 1)] = f2bf(x[i] * s + x[32 + i] * c); }
}
__global__ void nk_ssq(const bf16_t* __restrict__ cqkv, float* __restrict__ ssq) {
    const int idx = blockIdx.x * 256 + threadIdx.x; if (idx >= M_ * 2) return;
    const int m = idx >> 1, t = idx & 1; float s = 0.f;
    for (int i = 0; i < 256; ++i) { const float v = bf2f(cqkv[(size_t)m * 512 + t * 256 + i]); s += v * v; }
    ssq[m * 8 + t * 4] = s; ssq[m * 8 + t * 4 + 1] = 0.f; ssq[m * 8 + t * 4 + 2] = 0.f; ssq[m * 8 + t * 4 + 3] = 0.f;
}
__device__ __forceinline__ float ssq_rstd(const float* ssq, int m, int t) { const float* p = ssq + m * 8 + t * 4; return rsqrtf(((p[0] + p[1]) + (p[2] + p[3])) * (1.f / 256.f) + EPS); }
struct EpiUqN { bf16_t* qmla; const float* ssq;
    __device__ void operator()(int m, int n, float v, float) const { qmla[(size_t)m * 768 + n] = f2bf(v * ssq_rstd(ssq, m, 0)); } };
struct EpiUkvN { bf16_t *knope, *vmla; const float* ssq;
    __device__ void operator()(int m, int n, float v, float) const { v *= ssq_rstd(ssq, m, 1); const int h = n >> 8, j = n & 255;
        if (j < 128) knope[(size_t)m * 512 + h * 128 + j] = f2bf(v); else vmla[(size_t)m * 512 + h * 128 + j - 128] = f2bf(v); } };
struct EpiSwigluN { bf16_t* F; __device__ void operator()(int m, int n, float g, float u) const { F[(size_t)m * DFF + n] = f2bf(siluf_(g) * u); } };
struct EpiOinN { bf16_t *xb, *gate; __device__ void operator()(int m, int n, float v, float) const { if (n < 1024) xb[(size_t)m * 1024 + n] = f2bf(v); else gate[(size_t)m * 1024 + n - 1024] = f2bf(gelu_tanhf_(v)); } };
struct EpiLruN { bf16_t *la, *u; const bf16_t* xc; const float *ba, *bx, *ap; int blk, pad;
    __device__ void operator()(int m, int n, float v1, float v2) const { const int col = blk * 256 + n;
        const float r = sigmoidf_(v1 + ba[col]), i = sigmoidf_(v2 + bx[col]);
        const float l = -8.f * r * softplusf_(-ap[col]); const float mult = sqrtf(fmaxf(-expm1f(2.f * l), 0.f));
        la[(size_t)m * 1024 + col] = f2bf(l); u[(size_t)m * 1024 + col] = f2bf(mult * i * bf2f(xc[(size_t)m * 1024 + col])); } };

__global__ void __launch_bounds__(256) nk_gdn_prep(const bf16_t* __restrict__ qk, const bf16_t* __restrict__ vb, const float* __restrict__ ab, const float* __restrict__ convw,
                                                   const float* __restrict__ a_log, const float* __restrict__ dt_bias,
                                                   bf16_t* __restrict__ qh, bf16_t* __restrict__ kT, bf16_t* __restrict__ wout, bf16_t* __restrict__ uT, bf16_t* __restrict__ aqk,
                                                   float* __restrict__ egc, float* __restrict__ edec, float* __restrict__ egl) {
    extern __shared__ float sm[];
    float* qs = sm;
    float* ks = qs + 64 * 129;
    float* L = ks + 64 * 129;
    float* R = L + 64 * 65;
    float* gc = R + 64 * 257;
    float* bet = gc + 64;
    const int tid = threadIdx.x, blk = blockIdx.x, b = blk >> 7, h = (blk >> 5) & 3, n = blk & 31;
    const int t0 = n * 64; const size_t row0 = (size_t)b * T_ + t0;
    if (tid < 64) { const float a = ab[(row0 + tid) * 8 + h], bb = ab[(row0 + tid) * 8 + 4 + h];
        bet[tid] = sigmoidf_(bb); gc[tid] = -__expf(a_log[h]) * softplusf_(a + dt_bias[h]); }
    __syncthreads();
    if (tid == 0) { float s = 0.f; for (int c = 0; c < 64; ++c) { s += gc[c]; gc[c] = s; } }
    __syncthreads();
    for (int idx = tid; idx < 64 * 128; idx += 256) { const int c = idx >> 7, d = idx & 127;
        float aq = 0.f, ak = 0.f, av = 0.f;
#pragma unroll
        for (int j = 0; j < 4; ++j) { const int t = t0 + c - 3 + j; if (t < 0) continue; const size_t r = (size_t)b * T_ + t;
            aq += convw[j * 1536 + h * 128 + d] * bf2f(qk[r * 1024 + h * 128 + d]);
            ak += convw[j * 1536 + 512 + h * 128 + d] * bf2f(qk[r * 1024 + 512 + h * 128 + d]);
            av += convw[j * 1536 + 1024 + h * 128 + d] * bf2f(vb[r * 512 + h * 128 + d]); }
        qs[c * 129 + d] = siluf_(aq); ks[c * 129 + d] = siluf_(ak); R[c * 257 + d] = siluf_(av); }
    __syncthreads();
    if (tid < 64) { const int c = tid; float nq = 0.f, nk = 0.f;
        for (int d = 0; d < 128; ++d) { nq += qs[c * 129 + d] * qs[c * 129 + d]; nk += ks[c * 129 + d] * ks[c * 129 + d]; }
        const float rq = rsqrtf(nq + EPS) * 0.08838834764831845f, rk = rsqrtf(nk + EPS);
        for (int d = 0; d < 128; ++d) { qs[c * 129 + d] *= rq; ks[c * 129 + d] *= rk; }
        egc[(size_t)(b * 4 + h) * T_ + t0 + c] = __expf(gc[c]); edec[(size_t)(b * 4 + h) * T_ + t0 + c] = __expf(gc[63] - gc[c]);
        if (c == 0) egl[blk] = __expf(gc[63]); }
    __syncthreads();
    for (int idx = tid; idx < 64 * 128; idx += 256) { const int c = idx >> 7, d = idx & 127;
        qh[(row0 + c) * 512 + h * 128 + d] = f2bf(qs[c * 129 + d]); }
    for (int idx = tid; idx < 64 * 128; idx += 256) { const int d = idx >> 6, c = idx & 63;
        kT[((size_t)blk * 128 + d) * 64 + c] = f2bf(ks[c * 129 + d]); }
    for (int idx = tid; idx < 64 * 64; idx += 256) { const int c = idx >> 6, s = idx & 63;
        float dk = 0.f, dq = 0.f;
        if (s <= c) { for (int d = 0; d < 128; ++d) { dk += ks[c * 129 + d] * ks[s * 129 + d]; dq += qs[c * 129 + d] * ks[s * 129 + d]; } }
        const float dec = (s <= c) ? __expf(gc[c] - gc[s]) : 0.f;
        L[c * 65 + s] = (s < c) ? bet[c] * dk * dec : 0.f;
        aqk[(size_t)blk * 4096 + c * 64 + s] = f2bf((s <= c) ? dq * dec : 0.f); }
    for (int idx = tid; idx < 64 * 128; idx += 256) { const int c = idx >> 7, d = idx & 127;
        R[c * 257 + d] *= bet[c]; R[c * 257 + 128 + d] = ks[c * 129 + d] * bet[c] * __expf(gc[c]); }
    __syncthreads();
    { const int j = tid;
        for (int c = 1; c < 64; ++c) { float acc = R[c * 257 + j]; for (int s = 0; s < c; ++s) acc -= L[c * 65 + s] * R[s * 257 + j]; R[c * 257 + j] = acc; } }
    __syncthreads();
    for (int idx = tid; idx < 64 * 128; idx += 256) { const int d = idx >> 6, c = idx & 63; uT[((size_t)blk * 128 + d) * 64 + c] = f2bf(R[c * 257 + d]); }
    for (int idx = tid; idx < 64 * 128; idx += 256) { const int c = idx >> 7, d = idx & 127; wout[(row0 + c) * 512 + h * 128 + d] = f2bf(R[c * 257 + 128 + d]); }
}
constexpr int GDN_PREP_LDS = (64 * 129 * 2 + 64 * 65 + 64 * 257 + 128) * 4;

__global__ void __launch_bounds__(256) nk_gdn_rec(const bf16_t* __restrict__ qh, const bf16_t* __restrict__ kT, const bf16_t* __restrict__ w, const bf16_t* __restrict__ uT, const bf16_t* __restrict__ aqk,
                                                  const float* __restrict__ egc, const float* __restrict__ edec, const float* __restrict__ egl, float* __restrict__ obuf) {
    __shared__ float S[128][33]; __shared__ float vn[64][33];
    const int tid = threadIdx.x, bh = blockIdx.x >> 2, dv0 = (blockIdx.x & 3) * 32, b = bh >> 2, h = bh & 3;
    for (int i = tid; i < 128 * 33; i += 256) (&S[0][0])[i] = 0.f;
    __syncthreads();
    for (int n = 0; n < 32; ++n) {
        const int chunk = bh * 32 + n; const size_t row0 = (size_t)b * T_ + n * 64;
        { const int c = tid >> 2, dg = (tid & 3) * 8; float acc[8];
#pragma unroll
            for (int e = 0; e < 8; ++e) acc[e] = bf2f(uT[((size_t)chunk * 128 + dv0 + dg + e) * 64 + c]);
            for (int dk = 0; dk < 128; ++dk) { const float wv = bf2f(w[(row0 + c) * 512 + h * 128 + dk]);
#pragma unroll
                for (int e = 0; e < 8; ++e) acc[e] -= wv * S[dk][dg + e]; }
#pragma unroll
            for (int e = 0; e < 8; ++e) vn[c][dg + e] = acc[e]; }
        __syncthreads();
        { const int c = tid >> 2, dg = (tid & 3) * 8; float acc[8], acc2[8];
#pragma unroll
            for (int e = 0; e < 8; ++e) { acc[e] = 0.f; acc2[e] = 0.f; }
            for (int dk = 0; dk < 128; ++dk) { const float qv = bf2f(qh[(row0 + c) * 512 + h * 128 + dk]);
#pragma unroll
                for (int e = 0; e < 8; ++e) acc[e] += qv * S[dk][dg + e]; }
            for (int s = 0; s < 64; ++s) { const float av = bf2f(aqk[(size_t)chunk * 4096 + c * 64 + s]);
#pragma unroll
                for (int e = 0; e < 8; ++e) acc2[e] += av * vn[s][dg + e]; }
            const float eg = egc[(size_t)bh * T_ + n * 64 + c];
#pragma unroll
            for (int e = 0; e < 8; ++e) obuf[(row0 + c) * 512 + h * 128 + dv0 + dg + e] = eg * acc[e] + acc2[e]; }
        __syncthreads();
        { const int dk = tid >> 1, dg = (tid & 1) * 16; float acc[16]; const float el = egl[chunk];
#pragma unroll
            for (int e = 0; e < 16; ++e) acc[e] = S[dk][dg + e] * el;
            for (int c = 0; c < 64; ++c) { const float kv = bf2f(kT[((size_t)chunk * 128 + dk) * 64 + c]) * edec[(size_t)bh * T_ + n * 64 + c];
#pragma unroll
                for (int e = 0; e < 16; ++e) acc[e] += kv * vn[c][dg + e]; }
#pragma unroll
            for (int e = 0; e < 16; ++e) S[dk][dg + e] = acc[e]; }
        __syncthreads();
    }
}
__global__ void nk_gdn_gate(const float* __restrict__ obuf, const bf16_t* __restrict__ zb, const float* __restrict__ onorm, bf16_t* __restrict__ mix) {
    const int idx = blockIdx.x * 4 + (threadIdx.x >> 6), lane = threadIdx.x & 63; if (idx >= M_ * 4) return;
    const int m = idx >> 2, h = idx & 3;
    const float o0 = obuf[(size_t)m * 512 + h * 128 + lane * 2], o1 = obuf[(size_t)m * 512 + h * 128 + lane * 2 + 1];
    const float r = rsqrtf(wave_sum(o0 * o0 + o1 * o1) * (1.f / 128.f) + EPS);
    const float z0 = bf2f(zb[(size_t)m * 512 + h * 128 + lane * 2]), z1 = bf2f(zb[(size_t)m * 512 + h * 128 + lane * 2 + 1]);
    mix[(size_t)m * 1024 + h * 128 + lane * 2] = f2bf(o0 * r * onorm[lane * 2] * siluf_(z0));
    mix[(size_t)m * 1024 + h * 128 + lane * 2 + 1] = f2bf(o1 * r * onorm[lane * 2 + 1] * siluf_(z1));
}

struct AttnP { const bf16_t* Q; int ldq, qhs;
               const bf16_t* K1; int ldk1, k1hs;
               const bf16_t* K2; int ldk2, pad0;
               const bf16_t* V; int ldv, vhs;
               bf16_t* O; int ldo, ohs, ooff;
               int kv_rows_per_b, q_rows_per_b; int causal; float scale; int pad1; };
template <int D1, int D2, int DV, int KT>
__global__ void __launch_bounds__(256) nk_attn(AttnP p, int nkt_full) {
    constexpr int DQ = D1 + D2;
    extern __shared__ float sm[];
    float* Qs = sm;
    float* Ks = Qs + 64 * (DQ + 1);
    float* Vs = Ks + KT * (DQ + 1);
    float* Ps = Vs + KT * (DV + 1);
    const int tid = threadIdx.x, qc = blockIdx.x, h = blockIdx.y, b = blockIdx.z;
    const size_t qrow0 = (size_t)b * p.q_rows_per_b + qc * 64, krow0 = (size_t)b * p.kv_rows_per_b;
    for (int i = tid; i < 64 * DQ; i += 256) { const int q = i / DQ, d = i % DQ; Qs[q * (DQ + 1) + d] = bf2f(p.Q[(qrow0 + q) * p.ldq + h * p.qhs + d]); }
    const int q = tid >> 2, part = tid & 3;
    constexpr int KPT = KT / 4, DPT = DV / 4;
    float o[DPT]; float mrun = -1e30f, l = 0.f;
#pragma unroll
    for (int d = 0; d < DPT; ++d) o[d] = 0.f;
    const int nkt = p.causal ? (qc * 64 / KT + 64 / KT) : nkt_full;
    for (int kt = 0; kt < nkt; ++kt) {
        __syncthreads();
        for (int i = tid; i < KT * D1; i += 256) { const int k = i / D1, d = i % D1; Ks[k * (DQ + 1) + d] = bf2f(p.K1[(krow0 + kt * KT + k) * p.ldk1 + h * p.k1hs + d]); }
        if (D2 > 0) for (int i = tid; i < KT * D2; i += 256) { const int k = i / (D2 > 0 ? D2 : 1), d = i % (D2 > 0 ? D2 : 1); Ks[k * (DQ + 1) + D1 + d] = bf2f(p.K2[(krow0 + kt * KT + k) * p.ldk2 + d]); }
        for (int i = tid; i < KT * DV; i += 256) { const int k = i / DV, d = i % DV; Vs[k * (DV + 1) + d] = bf2f(p.V[(krow0 + kt * KT + k) * p.ldv + h * p.vhs + d]); }
        __syncthreads();
        float s[KPT]; float mx = -1e30f;
#pragma unroll
        for (int i = 0; i < KPT; ++i) { const int k = part * KPT + i; float acc = 0.f;
            for (int d = 0; d < DQ; ++d) acc += Qs[q * (DQ + 1) + d] * Ks[k * (DQ + 1) + d];
            s[i] = acc * p.scale; mx = fmaxf(mx, s[i]); }
        mx = fmaxf(mx, __shfl_xor(mx, 1)); mx = fmaxf(mx, __shfl_xor(mx, 2));
        const float mnew = fmaxf(mrun, mx), alpha = __expf(mrun - mnew); float ps = 0.f;
#pragma unroll
        for (int i = 0; i < KPT; ++i) { const float pv = __expf(s[i] - mnew); ps += pv; Ps[q * (KT + 1) + part * KPT + i] = pv; }
        ps += __shfl_xor(ps, 1); ps += __shfl_xor(ps, 2);
        l = l * alpha + ps; mrun = mnew;
#pragma unroll
        for (int d = 0; d < DPT; ++d) o[d] *= alpha;
        __syncthreads();
        for (int k = 0; k < KT; ++k) { const float pv = Ps[q * (KT + 1) + k];
#pragma unroll
            for (int d = 0; d < DPT; ++d) o[d] += pv * Vs[k * (DV + 1) + part * DPT + d]; }
    }
    const float inv = 1.f / l;
#pragma unroll
    for (int d = 0; d < DPT; ++d) p.O[(qrow0 + q) * p.ldo + p.ooff + h * p.ohs + part * DPT + d] = f2bf(o[d] * inv);
}
template <int D1, int D2, int DV, int KT> constexpr int attn_lds() { return (64 * (D1 + D2 + 1) + KT * (D1 + D2 + 1) + KT * (DV + 1) + 64 * (KT + 1)) * 4; }

__global__ void nk_conv_lru(const bf16_t* __restrict__ xb, const float* __restrict__ cw, const float* __restrict__ cb, bf16_t* __restrict__ xc) {
    const size_t idx = (size_t)blockIdx.x * 256 + threadIdx.x; if (idx >= (size_t)M_ * 1024) return;
    const int c = (int)(idx & 1023); const size_t m = idx >> 10; const int t = (int)(m % T_);
    float acc = cb[c];
#pragma unroll
    for (int j = 0; j < 4; ++j) { if (t - 3 + j < 0) continue; acc += cw[j * 1024 + c] * bf2f(xb[(m - 3 + j) * 1024 + c]); }
    xc[idx] = f2bf(acc);
}
__global__ void nk_lru_agg(const bf16_t* __restrict__ la, const bf16_t* __restrict__ u, float* __restrict__ aggA, float* __restrict__ aggH) {
    const int idx = blockIdx.x * 256 + threadIdx.x; if (idx >= B_ * 32 * 1024) return;
    const int c = idx & 1023, ch = (idx >> 10) & 31, b = idx >> 15;
    float sa = 0.f, hh = 0.f; const size_t r0 = (size_t)b * T_ + ch * 64;
    for (int t = 0; t < 64; ++t) { const float l = bf2f(la[(r0 + t) * 1024 + c]); sa += l; hh = __expf(l) * hh + bf2f(u[(r0 + t) * 1024 + c]); }
    aggA[idx] = sa; aggH[idx] = hh;
}
__global__ void nk_lru_apply(const bf16_t* __restrict__ la, const bf16_t* __restrict__ u, const float* __restrict__ aggA, const float* __restrict__ aggH, const bf16_t* __restrict__ gate, bf16_t* __restrict__ out) {
    const int idx = blockIdx.x * 256 + threadIdx.x; if (idx >= B_ * 32 * 1024) return;
    const int c = idx & 1023, ch = (idx >> 10) & 31, b = idx >> 15;
    float hh = 0.f;
    for (int j = 0; j < ch; ++j) hh = __expf(aggA[(b * 32 + j) * 1024 + c]) * hh + aggH[(b * 32 + j) * 1024 + c];
    const size_t r0 = (size_t)b * T_ + ch * 64;
    for (int t = 0; t < 64; ++t) { const float l = bf2f(la[(r0 + t) * 1024 + c]); hh = __expf(l) * hh + bf2f(u[(r0 + t) * 1024 + c]); out[(r0 + t) * 1024 + c] = f2bf(hh * bf2f(gate[(r0 + t) * 1024 + c])); }
}

template <bool DUAL, class Epi>
static void gemm_n(hipStream_t st, const bf16_t* A, int lda, const float* W, const float* W2, int ldw, int M, int N, int K, const float* ks, Epi e) {
    dim3 g((N + 255) / 256, M / (DUAL ? 16 : 32));
    hipLaunchKernelGGL((nk_gemm<DUAL, Epi>), g, dim3(256), 0, st, A, lda, W, W2, ldw, N, K, ks, e);
}

extern "C" void kernel_launch(void* const* d_in, const int* in_sizes, int n_in, void* d_out, int out_size, void* d_ws, size_t ws_size, hipStream_t stream) {
    static int init = 0;
    if (!init) {
        init = 1;
        if (ws_size < WS_END) fprintf(stderr, "kernel_launch: workspace too small: %zu\n", ws_size);
        hipFuncSetAttribute((const void*)nk_gdn_prep, hipFuncAttributeMaxDynamicSharedMemorySize, GDN_PREP_LDS);
        hipFuncSetAttribute((const void*)nk_attn<128, 64, 128, 64>, hipFuncAttributeMaxDynamicSharedMemorySize, attn_lds<128, 64, 128, 64>());
        hipFuncSetAttribute((const void*)nk_attn<256, 0, 256, 32>, hipFuncAttributeMaxDynamicSharedMemorySize, attn_lds<256, 0, 256, 32>());
    }
    const float* x = (const float*)d_in[0]; const float* mem = (const float*)d_in[1]; const int* pos = (const int*)d_in[2];
    const float* gains = (const float*)d_in[3]; const float* mem_norm = (const float*)d_in[4];
    const float* e_w_in = (const float*)d_in[5]; const float* e_conv_w = (const float*)d_in[6]; const float* e_a_log = (const float*)d_in[7]; const float* e_dt_bias = (const float*)d_in[8];
    const float* e_o_norm = (const float*)d_in[9]; const float* e_q_norm = (const float*)d_in[10]; const float* e_kv_norm = (const float*)d_in[11];
    const float* e_w_uq = (const float*)d_in[12]; const float* e_w_ukv = (const float*)d_in[13]; const float* e_w_out = (const float*)d_in[14];
    const float* o_w_in = (const float*)d_in[15]; const float* o_conv_w = (const float*)d_in[16]; const float* o_conv_b = (const float*)d_in[17];
    const float* o_gate_a_w = (const float*)d_in[18]; const float* o_gate_a_b = (const float*)d_in[19]; const float* o_gate_x_w = (const float*)d_in[20]; const float* o_gate_x_b = (const float*)d_in[21];
    const float* o_a_param = (const float*)d_in[22]; const float* o_w_out = (const float*)d_in[23];
    const float* xa_wq = (const float*)d_in[24]; const float* xa_wkv = (const float*)d_in[25]; const float* xa_wo = (const float*)d_in[26];
    const float* ffn_w_in = (const float*)d_in[27]; const float* ffn_w_out = (const float*)d_in[28];
    float* out = (float*)d_out; unsigned char* ws = (unsigned char*)d_ws;
    bf16_t* kvmem = (bf16_t*)(ws + WS_KVMEM); bf16_t* memn = (bf16_t*)(ws + WS_MEMN);
    float* ropec = (float*)(ws + WS_ROPEC); float* ropes = (float*)(ws + WS_ROPES);
    float* abuf = (float*)(ws + WS_ABUF); float* ssq = (float*)(ws + WS_SSQ); bf16_t* kpe = (bf16_t*)(ws + WS_KPE);
    float* egc = (float*)(ws + WS_EGC); float* edec = (float*)(ws + WS_EDEC); float* egl = (float*)(ws + WS_EGL);
    float* aggA = (float*)(ws + WS_AGG); float* aggH = aggA + B_ * 32 * 1024;
    bf16_t* hbuf = (bf16_t*)(ws + WS_H); bf16_t* wbuf = (bf16_t*)(ws + WS_H); bf16_t* uT = (bf16_t*)(ws + WS_H + 16 * MiB); bf16_t* labuf = (bf16_t*)(ws + WS_H);
    bf16_t* ybuf = (bf16_t*)(ws + WS_Y); bf16_t* vbuf = (bf16_t*)(ws + WS_Y); bf16_t* cqkv = (bf16_t*)(ws + WS_Y + 16 * MiB); float* obuf = (float*)(ws + WS_Y); bf16_t* xc = (bf16_t*)(ws + WS_Y);
    bf16_t* qkbuf = (bf16_t*)(ws + WS_QK); bf16_t* mixbuf = qkbuf; bf16_t* qx = qkbuf; bf16_t* xb = qkbuf; bf16_t* abuf2 = qkbuf;
    bf16_t* zbuf = (bf16_t*)(ws + WS_Z); bf16_t* ox = (bf16_t*)(ws + WS_Z); bf16_t* gatebuf = (bf16_t*)(ws + WS_Z); bf16_t* fbuf = (bf16_t*)(ws + WS_QK);
    bf16_t* qh = (bf16_t*)(ws + WS_G); bf16_t* kT = (bf16_t*)(ws + WS_G + 16 * MiB); bf16_t* aqk = (bf16_t*)(ws + WS_G + 32 * MiB);
    bf16_t* ubuf = (bf16_t*)(ws + WS_U);
    bf16_t* qmla = (bf16_t*)d_out; bf16_t* knope = (bf16_t*)((unsigned char*)d_out + 24 * MiB); bf16_t* vmla = (bf16_t*)((unsigned char*)d_out + 40 * MiB);

    hipLaunchKernelGGL(nk_rmsnorm, dim3(MM_ / 4), dim3(256), 0, stream, mem, mem_norm, memn, MM_);
    hipLaunchKernelGGL(nk_rmsnorm, dim3(M_ / 4), dim3(256), 0, stream, x, gains, hbuf, M_);
    hipLaunchKernelGGL(nk_ropetab, dim3(M_ * 32 / 256), dim3(256), 0, stream, pos, ropec, ropes);
    gemm_n<false>(stream, hbuf, 1024, e_w_in, nullptr, EIN, M_, EIN, 1024, nullptr, EpiEinN{qkbuf, vbuf, zbuf, cqkv, kpe, abuf});
    hipLaunchKernelGGL(nk_rope_inplace, dim3(M_ / 256), dim3(256), 0, stream, kpe, 64, 1, 0, 0, ropec, ropes);
    hipLaunchKernelGGL(nk_ssq, dim3(M_ * 2 / 256), dim3(256), 0, stream, cqkv, ssq);
    for (int l = 0; l < 2; ++l) gemm_n<false>(stream, memn, 1024, xa_wkv + (size_t)l * 1024 * 2048, nullptr, 2048, MM_, 2048, 1024, nullptr, EpiBf16N{kvmem + (size_t)l * 2048 * 2048, 2048, 0});
    hipLaunchKernelGGL(nk_gdn_prep, dim3(1024), dim3(256), GDN_PREP_LDS, stream, qkbuf, vbuf, abuf, e_conv_w, e_a_log, e_dt_bias, qh, kT, wbuf, uT, aqk, egc, edec, egl);
    gemm_n<false>(stream, cqkv, 512, e_w_uq, nullptr, 768, M_, 768, 256, e_q_norm, EpiUqN{qmla, ssq});
    hipLaunchKernelGGL(nk_rope_inplace, dim3(M_ * 4 / 256), dim3(256), 0, stream, qmla, 768, 4, 192, 128, ropec, ropes);
    gemm_n<false>(stream, cqkv + 256, 512, e_w_ukv, nullptr, 1024, M_, 1024, 256, e_kv_norm, EpiUkvN{knope, vmla, ssq});
    hipLaunchKernelGGL(nk_gdn_rec, dim3(128), dim3(256), 0, stream, qh, kT, wbuf, uT, aqk, egc, edec, egl, obuf);
    { AttnP p{qmla, 768, 192, knope, 512, 128, kpe, 64, 0, vmla, 512, 128, mixbuf, 1024, 128, 512, T_, T_, 1, 0.07216878364870322f, 0};
      hipLaunchKernelGGL((nk_attn<128, 64, 128, 64>), dim3(32, 4, B_), dim3(256), (attn_lds<128, 64, 128, 64>()), stream, p, 0); }
    hipLaunchKernelGGL(nk_gdn_gate, dim3(M_), dim3(256), 0, stream, obuf, zbuf, e_o_norm, mixbuf);
    gemm_n<false>(stream, mixbuf, 1024, e_w_out, nullptr, 1024, M_, 1024, 1024, nullptr, EpiBf16N{ybuf, 1024, 0});
    hipLaunchKernelGGL(nk_rowwise, dim3(M_ / 4), dim3(256), 0, stream, ybuf, x, out, gains + 1 * 1024, gains + 2 * 1024, hbuf);
    for (int l = 0; l < 2; ++l) {
        const float* g = gains + (size_t)l * 6 * 1024;
        if (l == 1) {
            gemm_n<false>(stream, hbuf, 1024, o_w_in, nullptr, 2048, M_, 2048, 1024, nullptr, EpiOinN{xb, gatebuf});
            hipLaunchKernelGGL(nk_conv_lru, dim3(M_ * 1024 / 256), dim3(256), 0, stream, xb, o_conv_w, o_conv_b, xc);
            for (int blk = 0; blk < 4; ++blk)
                gemm_n<true>(stream, xc + blk * 256, 1024, o_gate_a_w + (size_t)blk * 65536, o_gate_x_w + (size_t)blk * 65536, 256, M_, 256, 256, nullptr,
                             EpiLruN{labuf, ubuf, xc, o_gate_a_b, o_gate_x_b, o_a_param, blk, 0});
            hipLaunchKernelGGL(nk_lru_agg, dim3(B_ * 32 * 1024 / 256), dim3(256), 0, stream, labuf, ubuf, aggA, aggH);
            hipLaunchKernelGGL(nk_lru_apply, dim3(B_ * 32 * 1024 / 256), dim3(256), 0, stream, labuf, ubuf, aggA, aggH, gatebuf, abuf2);
            gemm_n<false>(stream, abuf2, 1024, o_w_out, nullptr, 1024, M_, 1024, 1024, nullptr, EpiBf16N{ybuf, 1024, 0});
            hipLaunchKernelGGL(nk_rowwise, dim3(M_ / 4), dim3(256), 0, stream, ybuf, out, out, g + 1 * 1024, g + 2 * 1024, hbuf);
        }
        gemm_n<false>(stream, hbuf, 1024, xa_wq + (size_t)l * 1024 * 1024, nullptr, 1024, M_, 1024, 1024, nullptr, EpiBf16N{qx, 1024, 0});
        { const bf16_t* kv = kvmem + (size_t)l * 2048 * 2048;
          AttnP p{qx, 1024, 256, kv, 2048, 256, nullptr, 0, 0, kv + 1024, 2048, 256, ox, 1024, 256, 0, NMEM, T_, 0, 0.0625f, 0};
          hipLaunchKernelGGL((nk_attn<256, 0, 256, 32>), dim3(32, 4, B_), dim3(256), (attn_lds<256, 0, 256, 32>()), stream, p, NMEM / 32); }
        gemm_n<false>(stream, ox, 1024, xa_wo + (size_t)l * 1024 * 1024, nullptr, 1024, M_, 1024, 1024, nullptr, EpiBf16N{ybuf, 1024, 0});
        hipLaunchKernelGGL(nk_rowwise, dim3(M_ / 4), dim3(256), 0, stream, ybuf, out, out, g + 3 * 1024, g + 4 * 1024, hbuf);
        { const float* wi = ffn_w_in + (size_t)l * 1024 * 5632;
          gemm_n<true>(stream, hbuf, 1024, wi, wi + DFF, 5632, M_, DFF, 1024, nullptr, EpiSwigluN{fbuf}); }
        gemm_n<false>(stream, fbuf, DFF, ffn_w_out + (size_t)l * DFF * 1024, nullptr, 1024, M_, 1024, DFF, nullptr, EpiBf16N{ybuf, 1024, 0});
        hipLaunchKernelGGL(nk_rowwise, dim3(M_ / 4), dim3(256), 0, stream, ybuf, out, out, g + 5 * 1024, l == 0 ? gains + 6 * 1024 : nullptr, l == 0 ? hbuf : nullptr);
    }
}
```

```cpp
#include <hip/hip_runtime.h>
#include <stdint.h>
#include <cstdio>

typedef unsigned short bf16_t;

constexpr int B_ = 8, T_ = 2048, D_ = 1024, M_ = B_ * T_;
constexpr int NMEM = 256, MM_ = B_ * NMEM;
constexpr int DFF = 2816;
constexpr int EIN = 2632;
constexpr float EPS = 1e-6f;

constexpr size_t MiB = 1u << 20;
constexpr size_t WS_CTL = 0;
constexpr size_t WS_WT = 1 * MiB;
constexpr size_t WS_KVMEM = 66 * MiB;
constexpr size_t WS_MEMN = 82 * MiB;
constexpr size_t WS_ROPEC = 86 * MiB;
constexpr size_t WS_ROPES = 88 * MiB;
constexpr size_t WS_ABUF = 90 * MiB;
constexpr size_t WS_SSQ = 90 * MiB + 512 * 1024;
constexpr size_t WS_KPE = 91 * MiB;
constexpr size_t WS_EGC = 93 * MiB;
constexpr size_t WS_EDEC = 93 * MiB + 256 * 1024;
constexpr size_t WS_EGL = 93 * MiB + 512 * 1024;
constexpr size_t WS_AGG = 94 * MiB;
constexpr size_t WS_H = 96 * MiB;
constexpr size_t WS_Y = 128 * MiB;
constexpr size_t WS_QK = 160 * MiB;
constexpr size_t WS_Z = 192 * MiB;
constexpr size_t WS_G = 208 * MiB;
constexpr size_t WS_U = 224 * MiB;
constexpr size_t WS_END = 256 * MiB;

__device__ __forceinline__ float bf2f(bf16_t v) { return __uint_as_float((unsigned)v << 16); }
__device__ __forceinline__ bf16_t f2bf(float f) { unsigned u = __float_as_uint(f); return (bf16_t)((u + 0x7fffu + ((u >> 16) & 1u)) >> 16); }
__device__ __forceinline__ float sigmoidf_(float x) { return 1.f / (1.f + __expf(-x)); }
__device__ __forceinline__ float softplusf_(float x) { return fmaxf(x, 0.f) + log1pf(__expf(-fabsf(x))); }
__device__ __forceinline__ float siluf_(float x) { return x * sigmoidf_(x); }
__device__ __forceinline__ float gelu_tanhf_(float x) { const float u = 0.7978845608028654f * (x + 0.044715f * x * x * x); return 0.5f * x * (1.f + tanhf(u)); }
__device__ __forceinline__ float wave_sum(float v) {
#pragma unroll
    for (int o = 1; o < 64; o <<= 1) v += __shfl_xor(v, o);
    return v;
}
__host__ __device__ __forceinline__ int rope_perm(int i, int half) { return (i >> 2) * 8 + half * 4 + (i & 3); }

__global__ void nk_rmsnorm(const float* __restrict__ x, const float* __restrict__ g, bf16_t* __restrict__ out, int rows) {
    const int row = blockIdx.x * 4 + (threadIdx.x >> 6), lane = threadIdx.x & 63;
    if (row >= rows) return;
    const float4* xr = (const float4*)(x + (size_t)row * D_);
    float4 v[4]; float s = 0.f;
#pragma unroll
    for (int j = 0; j < 4; ++j) { v[j] = xr[lane + 64 * j]; s += v[j].x * v[j].x + v[j].y * v[j].y + v[j].z * v[j].z + v[j].w * v[j].w; }
    const float r = rsqrtf(wave_sum(s) * (1.f / D_) + EPS);
#pragma unroll
    for (int j = 0; j < 4; ++j) { const int c = (lane + 64 * j) * 4; const float4 gg = *(const float4*)(g + c);
        bf16_t* o = out + (size_t)row * D_ + c; o[0] = f2bf(v[j].x * r * gg.x); o[1] = f2bf(v[j].y * r * gg.y); o[2] = f2bf(v[j].z * r * gg.z); o[3] = f2bf(v[j].w * r * gg.w); }
}
__global__ void nk_ropetab(const int* __restrict__ pos, float* __restrict__ ct, float* __restrict__ st) {
    const int idx = blockIdx.x * 256 + threadIdx.x; if (idx >= M_ * 32) return;
    const int m = idx >> 5, i = idx & 31;
    const float inv = powf(10000.f, -(float)(2 * i) / 64.f);
    const float ang = (float)pos[m] * inv; float s, c; sincosf(ang, &s, &c); ct[idx] = c; st[idx] = s;
}
__global__ void nk_rowwise(const bf16_t* __restrict__ y, const float* xin, float* xout, const float* __restrict__ g1, const float* __restrict__ g2, bf16_t* __restrict__ h) {
    const int row = blockIdx.x * 4 + (threadIdx.x >> 6), lane = threadIdx.x & 63;
    float yv[16], xv[16]; float s = 0.f;
#pragma unroll
    for (int j = 0; j < 4; ++j) { const int c = (lane + 64 * j) * 4;
#pragma unroll
        for (int e = 0; e < 4; ++e) { yv[j * 4 + e] = bf2f(y[(size_t)row * D_ + c + e]); s += yv[j * 4 + e] * yv[j * 4 + e]; } }
    const float r1 = rsqrtf(wave_sum(s) * (1.f / D_) + EPS); float s2 = 0.f;
#pragma unroll
    for (int j = 0; j < 4; ++j) { const int c = (lane + 64 * j) * 4;
#pragma unroll
        for (int e = 0; e < 4; ++e) { const float xn = xin[(size_t)row * D_ + c + e] + yv[j * 4 + e] * r1 * g1[c + e]; xv[j * 4 + e] = xn; s2 += xn * xn; xout[(size_t)row * D_ + c + e] = xn; } }
    if (h) { const float r2 = rsqrtf(wave_sum(s2) * (1.f / D_) + EPS);
#pragma unroll
        for (int j = 0; j < 4; ++j) { const int c = (lane + 64 * j) * 4;
#pragma unroll
            for (int e = 0; e < 4; ++e) h[(size_t)row * D_ + c + e] = f2bf(xv[j * 4 + e] * r2 * g2[c + e]); } }
}

template <bool DUAL, class Epi>
__global__ void __launch_bounds__(256) nk_gemm(const bf16_t* __restrict__ A, int lda, const float* __restrict__ W, const float* __restrict__ W2, int ldw, int N, int K, const float* __restrict__ ks, Epi epi) {
    constexpr int R = DUAL ? 16 : 32;
    __shared__ float As[32][36];
    const int tid = threadIdx.x, n = blockIdx.x * 256 + tid, m0 = blockIdx.y * R;
    const int nn = n < N ? n : N - 1;
    float acc[R], acc2[R];
#pragma unroll
    for (int r = 0; r < R; ++r) { acc[r] = 0.f; acc2[r] = 0.f; }
    for (int k0 = 0; k0 < K; k0 += 32) {
        __syncthreads();
#pragma unroll
        for (int i = 0; i < R / 8; ++i) { const int e = tid + 256 * i, r = e >> 5, kk = e & 31; float a = bf2f(A[(size_t)(m0 + r) * lda + k0 + kk]); if (ks) a *= ks[k0 + kk]; As[r][kk] = a; }
        __syncthreads();
#pragma unroll 1
        for (int k4 = 0; k4 < 8; ++k4) {
            float w[4], w2[4];
#pragma unroll
            for (int e = 0; e < 4; ++e) { w[e] = W[(size_t)(k0 + k4 * 4 + e) * ldw + nn]; w2[e] = DUAL ? W2[(size_t)(k0 + k4 * 4 + e) * ldw + nn] : 0.f; }
#pragma unroll
            for (int r = 0; r < R; ++r) { const float4 a = *(const float4*)&As[r][k4 * 4];
                acc[r] += a.x * w[0] + a.y * w[1] + a.z * w[2] + a.w * w[3];
                if (DUAL) acc2[r] += a.x * w2[0] + a.y * w2[1] + a.z * w2[2] + a.w * w2[3]; }
        }
    }
    if (n < N) {
#pragma unroll
        for (int r = 0; r < R; ++r) epi(m0 + r, n, acc[r], acc2[r]);
    }
}
struct EpiBf16N { bf16_t* O; int ldo, pad; __device__ void operator()(int m, int n, float v, float) const { O[(size_t)m * ldo + n] = f2bf(v); } };
struct EpiEinN { bf16_t *qk, *vb, *zb, *cqkv, *kpe; float* ab;
    __device__ void operator()(int m, int n, float v, float) const {
        if (n < 1024) qk[(size_t)m * 1024 + n] = f2bf(v);
        else if (n < 1536) vb[(size_t)m * 512 + n - 1024] = f2bf(v);
        else if (n < 2048) zb[(size_t)m * 512 + n - 1536] = f2bf(v);
        else if (n < 2056) ab[(size_t)m * 8 + n - 2048] = v;
        else if (n < 2568) cqkv[(size_t)m * 512 + n - 2056] = f2bf(v);
        else kpe[(size_t)m * 64 + n - 2568] = f2bf(v);
    } };
__global__ void nk_rope_inplace(bf16_t* __restrict__ buf, int ld, int nheads, int hstride, int off, const float* __restrict__ ct, const float* __restrict__ st) {
    const int idx = blockIdx.x * 256 + threadIdx.x; if (idx >= M_ * nheads) return;
    const int m = idx / nheads, h = idx % nheads;
    bf16_t* p = buf + (size_t)m * ld + h * hstride + off;
    float x[64];
#pragma unroll
    for (int i = 0; i < 64; ++i) x[i] = bf2f(p[i]);
#pragma unroll
    for (int i = 0; i < 32; ++i) { const float c = ct[m * 32 + i], s = st[m * 32 + i];
        p[rope_perm(i, 0)] = f2bf(x[i] * c - x[32 + i] * s); p[rope_perm(i, 1)] = f2bf(x[i] * s + x[32 + i] * c); }
}
__global__ void nk_ssq(const bf16_t* __restrict__ cqkv, float* __restrict__ ssq) {
    const int idx = blockIdx.x * 256 + threadIdx.x; if (idx >= M_ * 2) return;
    const int m = idx >> 1, t = idx & 1; float s = 0.f;
    for (int i = 0; i < 256; ++i) { const float v = bf2f(cqkv[(size_t)m * 512 + t * 256 + i]); s += v * v; }
    ssq[m * 8 + t * 4] = s; ssq[m * 8 + t * 4 + 1] = 0.f; ssq[m * 8 + t * 4 + 2] = 0.f; ssq[m * 8 + t * 4 + 3] = 0.f;
}
__device__ __forceinline__ float ssq_rstd(const float* ssq, int m, int t) { const float* p = ssq + m * 8 + t * 4; return rsqrtf(((p[0] + p[1]) + (p[2] + p[3])) * (1.f / 256.f) + EPS); }
struct EpiUqN { bf16_t* qmla; const float* ssq;
    __device__ void operator()(int m, int n, float v, float) const { qmla[(size_t)m * 768 + n] = f2bf(v * ssq_rstd(ssq, m, 0)); } };
struct EpiUkvN { bf16_t *knope, *vmla; const float* ssq;
    __device__ void operator()(int m, int n, float v, float) const { v *= ssq_rstd(ssq, m, 1); const int h = n >> 8, j = n & 255;
        if (j < 128) knope[(size_t)m * 512 + h * 128 + j] = f2bf(v); else vmla[(size_t)m * 512 + h * 128 + j - 128] = f2bf(v); } };
struct EpiSwigluN { bf16_t* F; __device__ void operator()(int m, int n, float g, float u) const { F[(size_t)m * DFF + n] = f2bf(siluf_(g) * u); } };
struct EpiOinN { bf16_t *xb, *gate; __device__ void operator()(int m, int n, float v, float) const { if (n < 1024) xb[(size_t)m * 1024 + n] = f2bf(v); else gate[(size_t)m * 1024 + n - 1024] = f2bf(gelu_tanhf_(v)); } };
struct EpiLruN { bf16_t *la, *u; const bf16_t* xc; const float *ba, *bx, *ap; int blk, pad;
    __device__ void operator()(int m, int n, float v1, float v2) const { const int col = blk * 256 + n;
        const float r = sigmoidf_(v1 + ba[col]), i = sigmoidf_(v2 + bx[col]);
        const float l = -8.f * r * softplusf_(-ap[col]); const float mult = sqrtf(fmaxf(-expm1f(2.f * l), 0.f));
        la[(size_t)m * 1024 + col] = f2bf(l); u[(size_t)m * 1024 + col] = f2bf(mult * i * bf2f(xc[(size_t)m * 1024 + col])); } };

__global__ void __launch_bounds__(256) nk_gdn_prep(const bf16_t* __restrict__ qk, const bf16_t* __restrict__ vb, const float* __restrict__ ab, const float* __restrict__ convw,
                                                   const float* __restrict__ a_log, const float* __restrict__ dt_bias,
                                                   bf16_t* __restrict__ qh, bf16_t* __restrict__ kT, bf16_t* __restrict__ wout, bf16_t* __restrict__ uT, bf16_t* __restrict__ aqk,
                                                   float* __restrict__ egc, float* __restrict__ edec, float* __restrict__ egl) {
    extern __shared__ float sm[];
    float* qs = sm;
    float* ks = qs + 64 * 129;
    float* L = ks + 64 * 129;
    float* R = L + 64 * 65;
    float* gc = R + 64 * 257;
    float* bet = gc + 64;
    const int tid = threadIdx.x, blk = blockIdx.x, b = blk >> 7, h = (blk >> 5) & 3, n = blk & 31;
    const int t0 = n * 64; const size_t row0 = (size_t)b * T_ + t0;
    if (tid < 64) { const float a = ab[(row0 + tid) * 8 + h], bb = ab[(row0 + tid) * 8 + 4 + h];
        bet[tid] = sigmoidf_(bb); gc[tid] = -__expf(a_log[h]) * softplusf_(a + dt_bias[h]); }
    __syncthreads();
    if (tid == 0) { float s = 0.f; for (int c = 0; c < 64; ++c) { s += gc[c]; gc[c] = s; } }
    __syncthreads();
    for (int idx = tid; idx < 64 * 128; idx += 256) { const int c = idx >> 7, d = idx & 127;
        float aq = 0.f, ak = 0.f, av = 0.f;
#pragma unroll
        for (int j = 0; j < 4; ++j) { const int t = t0 + c - 3 + j; if (t < 0) continue; const size_t r = (size_t)b * T_ + t;
            aq += convw[j * 1536 + h * 128 + d] * bf2f(qk[r * 1024 + h * 128 + d]);
            ak += convw[j * 1536 + 512 + h * 128 + d] * bf2f(qk[r * 1024 + 512 + h * 128 + d]);
            av += convw[j * 1536 + 1024 + h * 128 + d] * bf2f(vb[r * 512 + h * 128 + d]); }
        qs[c * 129 + d] = siluf_(aq); ks[c * 129 + d] = siluf_(ak); R[c * 257 + d] = siluf_(av); }
    __syncthreads();
    if (tid < 64) { const int c = tid; float nq = 0.f, nk = 0.f;
        for (int d = 0; d < 128; ++d) { nq += qs[c * 129 + d] * qs[c * 129 + d]; nk += ks[c * 129 + d] * ks[c * 129 + d]; }
        const float rq = rsqrtf(nq + EPS) * 0.08838834764831845f, rk = rsqrtf(nk + EPS);
        for (int d = 0; d < 128; ++d) { qs[c * 129 + d] *= rq; ks[c * 129 + d] *= rk; }
        egc[(size_t)(b * 4 + h) * T_ + t0 + c] = __expf(gc[c]); edec[(size_t)(b * 4 + h) * T_ + t0 + c] = __expf(gc[63] - gc[c]);
        if (c == 0) egl[blk] = __expf(gc[63]); }
    __syncthreads();
    for (int idx = tid; idx < 64 * 128; idx += 256) { const int c = idx >> 7, d = idx & 127;
        qh[(row0 + c) * 512 + h * 128 + d] = f2bf(qs[c * 129 + d]); }
    for (int idx = tid; idx < 64 * 128; idx += 256) { const int d = idx >> 6, c = idx & 63;
        kT[((size_t)blk * 128 + d) * 64 + c] = f2bf(ks[c * 129 + d]); }
    for (int idx = tid; idx < 64 * 64; idx += 256) { const int c = idx >> 6, s = idx & 63;
        float dk = 0.f, dq = 0.f;
        if (s <= c) { for (int d = 0; d < 128; ++d) { dk += ks[c * 129 + d] * ks[s * 129 + d]; dq += qs[c * 129 + d] * ks[s * 129 + d]; } }
        const float dec = (s <= c) ? __expf(gc[c] - gc[s]) : 0.f;
        L[c * 65 + s] = (s < c) ? bet[c] * dk * dec : 0.f;
        aqk[(size_t)blk * 4096 + c * 64 + s] = f2bf((s <= c) ? dq * dec : 0.f); }
    for (int idx = tid; idx < 64 * 128; idx += 256) { const int c = idx >> 7, d = idx & 127;
        R[c * 257 + d] *= bet[c]; R[c * 257 + 128 + d] = ks[c * 129 + d] * bet[c] * __expf(gc[c]); }
    __syncthreads();
    { const int j = tid;
        for (int c = 1; c < 64; ++c) { float acc = R[c * 257 + j]; for (int s = 0; s < c; ++s) acc -= L[c * 65 + s] * R[s * 257 + j]; R[c * 257 + j] = acc; } }
    __syncthreads();
    for (int idx = tid; idx < 64 * 128; idx += 256) { const int d = idx >> 6, c = idx & 63; uT[((size_t)blk * 128 + d) * 64 + c] = f2bf(R[c * 257 + d]); }
    for (int idx = tid; idx < 64 * 128; idx += 256) { const int c = idx >> 7, d = idx & 127; wout[(row0 + c) * 512 + h * 128 + d] = f2bf(R[c * 257 + 128 + d]); }
}
constexpr int GDN_PREP_LDS = (64 * 129 * 2 + 64 * 65 + 64 * 257 + 128) * 4;

__global__ void __launch_bounds__(256) nk_gdn_rec(const bf16_t* __restrict__ qh, const bf16_t* __restrict__ kT, const bf16_t* __restrict__ w, const bf16_t* __restrict__ uT, const bf16_t* __restrict__ aqk,
                                                  const float* __restrict__ egc, const float* __restrict__ edec, const float* __restrict__ egl, float* __restrict__ obuf) {
    __shared__ float S[128][33]; __shared__ float vn[64][33];
    const int tid = threadIdx.x, bh = blockIdx.x >> 2, dv0 = (blockIdx.x & 3) * 32, b = bh >> 2, h = bh & 3;
    for (int i = tid; i < 128 * 33; i += 256) (&S[0][0])[i] = 0.f;
    __syncthreads();
    for (int n = 0; n < 32; ++n) {
        const int chunk = bh * 32 + n; const size_t row0 = (size_t)b * T_ + n * 64;
        { const int c = tid >> 2, dg = (tid & 3) * 8; float acc[8];
#pragma unroll
            for (int e = 0; e < 8; ++e) acc[e] = bf2f(uT[((size_t)chunk * 128 + dv0 + dg + e) * 64 + c]);
            for (int dk = 0; dk < 128; ++dk) { const float wv = bf2f(w[(row0 + c) * 512 + h * 128 + dk]);
#pragma unroll
                for (int e = 0; e < 8; ++e) acc[e] -= wv * S[dk][dg + e]; }
#pragma unroll
            for (int e = 0; e < 8; ++e) vn[c][dg + e] = acc[e]; }
        __syncthreads();
        { const int c = tid >> 2, dg = (tid & 3) * 8; float acc[8], acc2[8];
#pragma unroll
            for (int e = 0; e < 8; ++e) { acc[e] = 0.f; acc2[e] = 0.f; }
            for (int dk = 0; dk < 128; ++dk) { const float qv = bf2f(qh[(row0 + c) * 512 + h * 128 + dk]);
#pragma unroll
                for (int e = 0; e < 8; ++e) acc[e] += qv * S[dk][dg + e]; }
            for (int s = 0; s < 64; ++s) { const float av = bf2f(aqk[(size_t)chunk * 4096 + c * 64 + s]);
#pragma unroll
                for (int e = 0; e < 8; ++e) acc2[e] += av * vn[s][dg + e]; }
            const float eg = egc[(size_t)bh * T_ + n * 64 + c];
#pragma unroll
            for (int e = 0; e < 8; ++e) obuf[(row0 + c) * 512 + h * 128 + dv0 + dg + e] = eg * acc[e] + acc2[e]; }
        __syncthreads();
        { const int dk = tid >> 1, dg = (tid & 1) * 16; float acc[16]; const float el = egl[chunk];
#pragma unroll
            for (int e = 0; e < 16; ++e) acc[e] = S[dk][dg + e] * el;
            for (int c = 0; c < 64; ++c) { const float kv = bf2f(kT[((size_t)chunk * 128 + dk) * 64 + c]) * edec[(size_t)bh * T_ + n * 64 + c];
#pragma unroll
                for (int e = 0; e < 16; ++e) acc[e] += kv * vn[c][dg + e]; }
#pragma unroll
            for (int e = 0; e < 16; ++e) S[dk][dg + e] = acc[e]; }
        __syncthreads();
    }
}
__global__ void nk_gdn_gate(const float* __restrict__ obuf, const bf16_t* __restrict__ zb, const float* __restrict__ onorm, bf16_t* __restrict__ mix) {
    const int idx = blockIdx.x * 4 + (threadIdx.x >> 6), lane = threadIdx.x & 63; if (idx >= M_ * 4) return;
    const int m = idx >> 2, h = idx & 3;
    const float o0 = obuf[(size_t)m * 512 + h * 128 + lane * 2], o1 = obuf[(size_t)m * 512 + h * 128 + lane * 2 + 1];
    const float r = rsqrtf(wave_sum(o0 * o0 + o1 * o1) * (1.f / 128.f) + EPS);
    const float z0 = bf2f(zb[(size_t)m * 512 + h * 128 + lane * 2]), z1 = bf2f(zb[(size_t)m * 512 + h * 128 + lane * 2 + 1]);
    mix[(size_t)m * 1024 + h * 128 + lane * 2] = f2bf(o0 * r * onorm[lane * 2] * siluf_(z0));
    mix[(size_t)m * 1024 + h * 128 + lane * 2 + 1] = f2bf(o1 * r * onorm[lane * 2 + 1] * siluf_(z1));
}

struct AttnP { const bf16_t* Q; int ldq, qhs;
               const bf16_t* K1; int ldk1, k1hs;
               const bf16_t* K2; int ldk2, pad0;
               const bf16_t* V; int ldv, vhs;
               bf16_t* O; int ldo, ohs, ooff;
               int kv_rows_per_b, q_rows_per_b; int causal; float scale; int pad1; };
template <int D1, int D2, int DV, int KT>
__global__ void __launch_bounds__(256) nk_attn(AttnP p, int nkt_full) {
    constexpr int DQ = D1 + D2;
    extern __shared__ float sm[];
    float* Qs = sm;
    float* Ks = Qs + 64 * (DQ + 1);
    float* Vs = Ks + KT * (DQ + 1);
    float* Ps = Vs + KT * (DV + 1);
    const int tid = threadIdx.x, qc = blockIdx.x, h = blockIdx.y, b = blockIdx.z;
    const size_t qrow0 = (size_t)b * p.q_rows_per_b + qc * 64, krow0 = (size_t)b * p.kv_rows_per_b;
    for (int i = tid; i < 64 * DQ; i += 256) { const int q = i / DQ, d = i % DQ; Qs[q * (DQ + 1) + d] = bf2f(p.Q[(qrow0 + q) * p.ldq + h * p.qhs + d]); }
    const int q = tid >> 2, part = tid & 3;
    constexpr int KPT = KT / 4, DPT = DV / 4;
    float o[DPT]; float mrun = -1e30f, l = 0.f;
#pragma unroll
    for (int d = 0; d < DPT; ++d) o[d] = 0.f;
    const int nkt = p.causal ? (qc * 64 / KT + 64 / KT) : nkt_full;
    for (int kt = 0; kt < nkt; ++kt) {
        __syncthreads();
        for (int i = tid; i < KT * D1; i += 256) { const int k = i / D1, d = i % D1; Ks[k * (DQ + 1) + d] = bf2f(p.K1[(krow0 + kt * KT + k) * p.ldk1 + h * p.k1hs + d]); }
        if (D2 > 0) for (int i = tid; i < KT * D2; i += 256) { const int k = i / (D2 > 0 ? D2 : 1), d = i % (D2 > 0 ? D2 : 1); Ks[k * (DQ + 1) + D1 + d] = bf2f(p.K2[(krow0 + kt * KT + k) * p.ldk2 + d]); }
        for (int i = tid; i < KT * DV; i += 256) { const int k = i / DV, d = i % DV; Vs[k * (DV + 1) + d] = bf2f(p.V[(krow0 + kt * KT + k) * p.ldv + h * p.vhs + d]); }
        __syncthreads();
        float s[KPT]; float mx = -1e30f;
#pragma unroll
        for (int i = 0; i < KPT; ++i) { const int k = part * KPT + i; float acc = 0.f;
            for (int d = 0; d < DQ; ++d) acc += Qs[q * (DQ + 1) + d] * Ks[k * (DQ + 1) + d];
            s[i] = acc * p.scale; mx = fmaxf(mx, s[i]); }
        mx = fmaxf(mx, __shfl_xor(mx, 1)); mx = fmaxf(mx, __shfl_xor(mx, 2));
        const float mnew = fmaxf(mrun, mx), alpha = __expf(mrun - mnew); float ps = 0.f;
#pragma unroll
        for (int i = 0; i < KPT; ++i) { const float pv = __expf(s[i] - mnew); ps += pv; Ps[q * (KT + 1) + part * KPT + i] = pv; }
        ps += __shfl_xor(ps, 1); ps += __shfl_xor(ps, 2);
        l = l * alpha + ps; mrun = mnew;
#pragma unroll
        for (int d = 0; d < DPT; ++d) o[d] *= alpha;
        __syncthreads();
        for (int k = 0; k < KT; ++k) { const float pv = Ps[q * (KT + 1) + k];
#pragma unroll
            for (int d = 0; d < DPT; ++d) o[d] += pv * Vs[k * (DV + 1) + part * DPT + d]; }
    }
    const float inv = 1.f / l;
#pragma unroll
    for (int d = 0; d < DPT; ++d) p.O[(qrow0 + q) * p.ldo + p.ooff + h * p.ohs + part * DPT + d] = f2bf(o[d] * inv);
}
template <int D1, int D2, int DV, int KT> constexpr int attn_lds() { return (64 * (D1 + D2 + 1) + KT * (D1 + D2 + 1) + KT * (DV + 1) + 64 * (KT + 1)) * 4; }

__global__ void nk_conv_lru(const bf16_t* __restrict__ xb, const float* __restrict__ cw, const float* __restrict__ cb, bf16_t* __restrict__ xc) {
    const size_t idx = (size_t)blockIdx.x * 256 + threadIdx.x; if (idx >= (size_t)M_ * 1024) return;
    const int c = (int)(idx & 1023); const size_t m = idx >> 10; const int t = (int)(m % T_);
    float acc = cb[c];
#pragma unroll
    for (int j = 0; j < 4; ++j) { if (t - 3 + j < 0) continue; acc += cw[j * 1024 + c] * bf2f(xb[(m - 3 + j) * 1024 + c]); }
    xc[idx] = f2bf(acc);
}
__global__ void nk_lru_agg(const bf16_t* __restrict__ la, const bf16_t* __restrict__ u, float* __restrict__ aggA, float* __restrict__ aggH) {
    const int idx = blockIdx.x * 256 + threadIdx.x; if (idx >= B_ * 32 * 1024) return;
    const int c = idx & 1023, ch = (idx >> 10) & 31, b = idx >> 15;
    float sa = 0.f, hh = 0.f; const size_t r0 = (size_t)b * T_ + ch * 64;
    for (int t = 0; t < 64; ++t) { const float l = bf2f(la[(r0 + t) * 1024 + c]); sa += l; hh = __expf(l) * hh + bf2f(u[(r0 + t) * 1024 + c]); }
    aggA[idx] = sa; aggH[idx] = hh;
}
__global__ void nk_lru_apply(const bf16_t* __restrict__ la, const bf16_t* __restrict__ u, const float* __restrict__ aggA, const float* __restrict__ aggH, const bf16_t* __restrict__ gate, bf16_t* __restrict__ out) {
    const int idx = blockIdx.x * 256 + threadIdx.x; if (idx >= B_ * 32 * 1024) return;
    const int c = idx & 1023, ch = (idx >> 10) & 31, b = idx >> 15;
    float hh = 0.f;
    for (int j = 0; j < ch; ++j) hh = __expf(aggA[(b * 32 + j) * 1024 + c]) * hh + aggH[(b * 32 + j) * 1024 + c];
    const size_t r0 = (size_t)b * T_ + ch * 64;
    for (int t = 0; t < 64; ++t) { const float l = bf2f(la[(r0 + t) * 1024 + c]); hh = __expf(l) * hh + bf2f(u[(r0 + t) * 1024 + c]); out[(r0 + t) * 1024 + c] = f2bf(hh * bf2f(gate[(r0 + t) * 1024 + c])); }
}

#define GAS __attribute__((address_space(1)))
#define LAS __attribute__((address_space(3)))
typedef unsigned v4u __attribute__((ext_vector_type(4)));
typedef unsigned v2u __attribute__((ext_vector_type(2)));
typedef GAS unsigned gu32;
#define RLX_AGENT __ATOMIC_RELAXED, __HIP_MEMORY_SCOPE_AGENT
#define LDS_WAIT() asm volatile("s_waitcnt lgkmcnt(0)" ::: "memory")
#define VM_WAIT() asm volatile("s_waitcnt vmcnt(0)" ::: "memory")
__device__ __forceinline__ unsigned pk2(float lo, float hi) { return (unsigned)f2bf(lo) | ((unsigned)f2bf(hi) << 16); }
constexpr int NWAVES = 8;
constexpr int RING_OFF = 0, RING_BYTES = 131072;
constexpr int LDSCTL_OFF = RING_BYTES, MISC_OFF = LDSCTL_OFF + 320;
constexpr int LDS_BYTES = 147456;
constexpr int CW_BAR = 4096;
constexpr size_t CTL_ZERO_BYTES = 512 * 1024;

#define XB_TMO      128
#define XB_XCNT(j)  (256  + 64 * (j))
#define XB_XSUB(j)  (1280 + 64 * (j))
#define XB_XGEN(j)  (2304 + 64 * (j))
#define XB_TOP      3328
#define XB_TOPGEN   3392
#define XCD_BAR_WORDS 3456
#define XB_SPIN_CAP (1u << 18)

__device__ __forceinline__ unsigned xb_ld(unsigned* p)              { return __hip_atomic_load(p, __ATOMIC_RELAXED, __HIP_MEMORY_SCOPE_AGENT); }
__device__ __forceinline__ unsigned xb_add(unsigned* p, unsigned v) { return __hip_atomic_fetch_add(p, v, __ATOMIC_RELAXED, __HIP_MEMORY_SCOPE_AGENT); }
__device__ __forceinline__ unsigned xb_xcc_id() { return (unsigned)__builtin_amdgcn_s_getreg((3 << 11) | 20) & 0xFu; }
#define XB_SPIN(cond, bar) do { unsigned _sp = 0; while (cond) { __builtin_amdgcn_s_sleep(1); \
    if ((++_sp & 255u) == 0u) { if (xb_ld(&(bar)[XB_TMO])) break; if (_sp > XB_SPIN_CAP) { atomicAdd(&(bar)[XB_TMO], 1u); break; } } } } while (0)

struct XcdBarrier {
    unsigned* bar; unsigned x;
    volatile LAS unsigned* st;
};

__device__ __forceinline__ XcdBarrier xcd_barrier_post(unsigned* bar, volatile LAS unsigned* st) {
    XcdBarrier b; b.bar = bar; b.x = xb_xcc_id(); b.st = st;
    if (threadIdx.x == 0) (void)xb_add(&bar[XB_XCNT(b.x)], 1u);
    return b;
}
__device__ __forceinline__ void xcd_barrier_complete(unsigned* bar, unsigned x, unsigned& nloc, unsigned& nx) {
    const unsigned G = gridDim.x * gridDim.y * gridDim.z;
    unsigned sum, cnt, mine, sp = 0u;
    for (;;) {
        sum = 0u; cnt = 0u; mine = 0u;
#pragma unroll
        for (unsigned j = 0; j < 16; ++j) { const unsigned c = xb_ld(&bar[XB_XCNT(j)]); sum += c; cnt += (c > 0u) ? 1u : 0u; mine = (j == x) ? c : mine; }
        if (sum == G) break;
        __builtin_amdgcn_s_sleep(1);
        if ((++sp & 255u) == 0u) { if (xb_ld(&bar[XB_TMO])) break; if (sp > XB_SPIN_CAP) { atomicAdd(&bar[XB_TMO], 1u); break; } }
    }
    nloc = mine > 0u ? mine : 1u; nx = cnt > 0u ? cnt : 1u;
}

__device__ __forceinline__ void xcd_barrier(const XcdBarrier& b) {
    asm volatile("s_waitcnt vmcnt(0)" ::: "memory");
    __syncthreads();
    if (threadIdx.x == 0) {
        unsigned* bar = b.bar;
        __builtin_amdgcn_s_waitcnt(0);
        unsigned nloc = b.st[0], nx = b.st[1];
        if (nloc == 0u) { xcd_barrier_complete(bar, b.x, nloc, nx); b.st[0] = nloc; b.st[1] = nx; }
        const unsigned old = xb_add(&bar[XB_XSUB(b.x)], 1u);
        const unsigned gen = old / nloc;
        if (old + 1u == (gen + 1u) * nloc) {
            __builtin_amdgcn_fence(__ATOMIC_RELEASE, "agent");
            asm volatile("s_waitcnt vmcnt(0)" ::: "memory");
            const unsigned og = xb_add(&bar[XB_TOP], 1u);
            const unsigned tg = og / nx;
            if (og + 1u == (tg + 1u) * nx) xb_add(&bar[XB_TOPGEN], 1u);
            else XB_SPIN(xb_ld(&bar[XB_TOPGEN]) == tg, bar);
            __builtin_amdgcn_fence(__ATOMIC_ACQUIRE, "agent");
            xb_add(&bar[XB_XGEN(b.x)], 1u);
            asm volatile("s_waitcnt vmcnt(0)" ::: "memory");
        } else {
            XB_SPIN(xb_ld(&bar[XB_XGEN(b.x)]) == gen, bar);
            __builtin_amdgcn_fence(__ATOMIC_ACQUIRE, "agent");
            asm volatile("s_waitcnt vmcnt(0)" ::: "memory");
        }
    }
    __syncthreads();
}

namespace pg8 {
#define PG8_LAS __attribute__((address_space(3)))
typedef short bf16x8 __attribute__((ext_vector_type(8)));
typedef float f32x4 __attribute__((ext_vector_type(4)));
typedef unsigned u32x4 __attribute__((ext_vector_type(4)));
constexpr int BM = 256, BK = 64, HALF = 128, HTB = HALF * BK * 2  , STAGE_BYTES = 8 * HTB, NXCD = 8, WGM = 8;

__host__ __device__ __forceinline__ int lds_byte(int r, int c) { const int st = (r >> 4) * 2 + (c >> 5), rr = r & 15, cc = c & 31, ob = rr * 64 + cc * 2; return st * 1024 + (ob ^ (((ob >> 9) & 1) << 5)); }
__host__ __device__ __forceinline__ void stage_rc(int b, int& R, int& C) { const int st = b / 1024, sb = b % 1024, swz = sb ^ (((sb >> 9) & 1) << 5); R = (st >> 1) * 16 + swz / 64; C = (st & 1) * 32 + (swz % 64) / 2; }
__host__ __device__ __forceinline__ int perm32(int rho) { const int n = rho >> 4, i = rho & 15; return 8 * (i >> 2) + 4 * n + (i & 3); }

struct Unit { int pm, pn; };
struct Gemm { const bf16_t* A; const bf16_t* Bt; int M, N, K, lda, a_tile_div, a_koff; };

struct StaticOrder {
    int nM, nN, nwg, G, c;
    __host__ __device__ void init(int M, int N, int G_, int c_, int rot = 0) { nM = M / BM; nN = N / BM; nwg = nM * nN; G = G_; c = (c_ + G_ - (rot % G_)) % G_; }
    __host__ __device__ bool next(int i, Unit& u) const {
        const long L = (long)i * G + c; if (L >= nwg) return false;
        int wgid = (int)L; { const int q = nwg / NXCD, r = nwg % NXCD, xcd = wgid % NXCD, off = wgid / NXCD; wgid = (xcd < r ? xcd * (q + 1) : r * (q + 1) + (xcd - r) * q) + off; }
        const int nig = WGM * nN, gid = wgid / nig, fm = gid * WGM, gsz = (nM - fm) < WGM ? (nM - fm) : WGM;
        u.pm = fm + ((wgid % nig) % gsz); u.pn = (wgid % nig) / gsz; return true;
    }
    __device__ __forceinline__ void a_ready(const Unit&) const {}
    __device__ __forceinline__ void done(const Unit&) const {}
};
__device__ __forceinline__ unsigned cvt_pk_bf16(float lo, float hi) { unsigned r; asm volatile("v_cvt_pk_bf16_f32 %0, %1, %2" : "=v"(r) : "v"(lo), "v"(hi)); return r; }
template <class Epi, class Sched, bool ALIGN_EPI = false, bool SP2 = false>
__device__ __forceinline__ void gemm_phase(PG8_LAS unsigned char* lds, const Gemm g, const Sched& S, const Epi& E) {
    const int tid = threadIdx.x, wid = __builtin_amdgcn_readfirstlane(tid >> 6), lane = tid & 63, wr = wid >> 2, wc = wid & 3, fr = lane & 15, fq = lane >> 4;
    const int K = g.K, nt = K / BK;
    unsigned voffA[2], voffB[2];
#pragma unroll
    for (int i = 0; i < 2; ++i) { int R, C; stage_rc(tid * 16 + i * 8192, R, C); const int Rb = Epi::PERM ? ((R & ~31) + perm32(R & 31)) : R;
        voffA[i] = (unsigned)(R * g.lda + C) * 2u; voffB[i] = (unsigned)(Rb * K + C) * 2u; }
    const size_t kstep = (size_t)(BK * 2);
    const size_t hstepA = (size_t)HALF * g.lda * 2, hstepB = (size_t)HALF * K * 2;
    const size_t tstepA = 2 * hstepA, tstepB = 2 * hstepB;
#define PG8_AOFF(u_) ((g.a_tile_div > 0) ? (size_t)((u_).pn / g.a_tile_div) * (size_t)g.a_koff * 2 : (size_t)0)
    const unsigned ldsw = (unsigned)wid * 1024u;
    const int aoff = lds_byte(wr * 64 + fr, fq * 8), boff = lds_byte(wc * 32 + fr, fq * 8);
#define PG8_SA(b, h) (((b) * 2 + (h)) * HTB)
#define PG8_SB(b, h) ((4 + (b) * 2 + (h)) * HTB)
#define PG8_STAGE(bufoff, gbase, voff) do { _Pragma("unroll") for (int _i = 0; _i < 2; ++_i) \
        __builtin_amdgcn_global_load_lds((const unsigned*)((const char*)(gbase) + (voff)[_i]), (PG8_LAS unsigned*)(lds + (bufoff) + ldsw + _i * 8192), 16, 0, 0); } while (0)
#define PG8_LDA(dst, b, h) do { _Pragma("unroll") for (int m = 0; m < 4; ++m) _Pragma("unroll") for (int k = 0; k < 2; ++k) dst[m][k] = *(const PG8_LAS bf16x8*)(lds + PG8_SA(b, h) + aoff + m * 2048 + k * 1024); } while (0)
#define PG8_LDB(dst, b, h) do { _Pragma("unroll") for (int n = 0; n < 2; ++n) _Pragma("unroll") for (int k = 0; k < 2; ++k) dst[n][k] = *(const PG8_LAS bf16x8*)(lds + PG8_SB(b, h) + boff + n * 2048 + k * 1024); } while (0)
#define PG8_MMA(ai, bj, At, Bt) do { __builtin_amdgcn_s_setprio(1); _Pragma("unroll") for (int m = 0; m < 4; ++m) _Pragma("unroll") for (int n = 0; n < 2; ++n) _Pragma("unroll") for (int k = 0; k < 2; ++k) \
        acc[ai][bj][m][n] = __builtin_amdgcn_mfma_f32_16x16x32_bf16(Bt[n][k], At[m][k], acc[ai][bj][m][n], 0, 0, 0); __builtin_amdgcn_s_setprio(0); } while (0)
#define PG8_WAIT_V(n) asm volatile("s_waitcnt vmcnt(" #n ")" ::: "memory")
#define PG8_WAIT_L(n) asm volatile("s_waitcnt lgkmcnt(" #n ")" ::: "memory")
#define PG8_BAR __builtin_amdgcn_s_barrier()
#define PG8_SCHED __builtin_amdgcn_sched_barrier(0)
    Unit cur, nxt; int ui = 0;
    if (!S.next(0, cur)) return;
    f32x4 acc[2][2][4][2];
#pragma unroll
    for (int a = 0; a < 2; ++a)
#pragma unroll
        for (int b = 0; b < 2; ++b)
#pragma unroll
            for (int m = 0; m < 4; ++m)
#pragma unroll
                for (int n = 0; n < 2; ++n) acc[a][b][m][n] = (f32x4){0.f, 0.f, 0.f, 0.f};
    bf16x8 At[4][2], B0[2][2], B1[2][2];
    const char* cA = (const char*)g.A + (size_t)cur.pm * tstepA + PG8_AOFF(cur); const char* cB = (const char*)g.Bt + (size_t)cur.pn * tstepB;
    S.a_ready(cur);
    if constexpr (SP2) {
        PG8_STAGE(PG8_SB(0, 0), cB, voffB); PG8_STAGE(PG8_SB(0, 1), cB + hstepB, voffB); PG8_STAGE(PG8_SA(0, 0), cA, voffA); PG8_STAGE(PG8_SA(0, 1), cA + hstepA, voffA);
        if (wr == 1) PG8_BAR;
        PG8_WAIT_V(2); PG8_BAR;
        PG8_STAGE(PG8_SB(1, 0), cB + kstep, voffB); PG8_STAGE(PG8_SA(1, 0), cA + kstep, voffA); PG8_STAGE(PG8_SB(1, 1), cB + hstepB + kstep, voffB);
        PG8_WAIT_V(6); PG8_BAR;
    } else {
        PG8_STAGE(PG8_SB(0, 0), cB, voffB); PG8_STAGE(PG8_SA(0, 0), cA, voffA); PG8_STAGE(PG8_SB(0, 1), cB + hstepB, voffB); PG8_STAGE(PG8_SA(0, 1), cA + hstepA, voffA);
        if (wr == 1) PG8_BAR;
        PG8_WAIT_V(4); PG8_BAR;
        PG8_STAGE(PG8_SB(1, 0), cB + kstep, voffB); PG8_STAGE(PG8_SA(1, 0), cA + kstep, voffA); PG8_STAGE(PG8_SB(1, 1), cB + hstepB + kstep, voffB);
        PG8_WAIT_V(6); PG8_BAR;
    }
    for (;;) {
        const bool has_next = S.next(ui + 1, nxt);
        const char* nA = has_next ? (const char*)g.A + (size_t)nxt.pm * tstepA + PG8_AOFF(nxt) : cA; const char* nB = has_next ? (const char*)g.Bt + (size_t)nxt.pn * tstepB : cB;
        for (int t = 0; t < nt; t += 2) {
            const bool last = (t == nt - 2);
            const char* a1 = cA + (size_t)(t + 1) * kstep;
            const char* a2 = last ? nA : cA + (size_t)(t + 2) * kstep; const char* b2 = last ? nB : cB + (size_t)(t + 2) * kstep;
            const char* a3 = a2 + kstep; const char* b3 = b2 + kstep;
            if (last && has_next) S.a_ready(nxt);
            if constexpr (SP2) {
            PG8_LDB(B0, 0, 0); PG8_LDB(B1, 0, 1); PG8_SCHED; PG8_LDA(At, 0, 0); PG8_STAGE(PG8_SA(1, 1), a1 + hstepA, voffA);
            PG8_WAIT_V(8); PG8_WAIT_L(0); PG8_BAR; PG8_MMA(0, 0, At, B0); PG8_MMA(0, 1, At, B1); PG8_BAR; PG8_SCHED;
            PG8_LDA(At, 0, 1); PG8_STAGE(PG8_SB(0, 0), b2, voffB); PG8_STAGE(PG8_SB(0, 1), b2 + hstepB, voffB); PG8_STAGE(PG8_SA(0, 0), a2, voffA);
            PG8_WAIT_V(8); PG8_WAIT_L(0); PG8_BAR; PG8_MMA(1, 0, At, B0); PG8_MMA(1, 1, At, B1); PG8_BAR; PG8_SCHED;
            PG8_LDB(B0, 1, 0); PG8_LDB(B1, 1, 1); PG8_SCHED; PG8_LDA(At, 1, 0); PG8_STAGE(PG8_SA(0, 1), a2 + hstepA, voffA);
            PG8_WAIT_V(8); PG8_WAIT_L(0); PG8_BAR; PG8_MMA(0, 0, At, B0); PG8_MMA(0, 1, At, B1); PG8_BAR; PG8_SCHED;
            PG8_LDA(At, 1, 1); PG8_STAGE(PG8_SB(1, 0), b3, voffB); PG8_STAGE(PG8_SB(1, 1), b3 + hstepB, voffB); PG8_STAGE(PG8_SA(1, 0), a3, voffA);
            PG8_WAIT_V(8); PG8_WAIT_L(0); PG8_BAR; PG8_MMA(1, 0, At, B0); PG8_MMA(1, 1, At, B1); PG8_BAR; PG8_SCHED;
            } else {
            PG8_LDB(B0, 0, 0); PG8_SCHED; PG8_LDA(At, 0, 0); PG8_STAGE(PG8_SA(1, 1), a1 + hstepA, voffA);
            PG8_WAIT_L(8); PG8_BAR; PG8_WAIT_L(0); PG8_MMA(0, 0, At, B0); PG8_BAR; PG8_SCHED;
            PG8_LDB(B1, 0, 1); PG8_STAGE(PG8_SB(0, 0), b2, voffB);
            PG8_BAR; PG8_WAIT_L(0); PG8_MMA(0, 1, At, B1); PG8_BAR;
            PG8_LDA(At, 0, 1); PG8_STAGE(PG8_SA(0, 0), a2, voffA);
            PG8_BAR; PG8_WAIT_L(0); PG8_MMA(1, 0, At, B0); PG8_BAR; PG8_SCHED;
            PG8_STAGE(PG8_SB(0, 1), b2 + hstepB, voffB);
            PG8_WAIT_V(6); PG8_BAR; PG8_MMA(1, 1, At, B1); PG8_BAR;
            PG8_LDB(B0, 1, 0); PG8_SCHED; PG8_LDA(At, 1, 0); PG8_STAGE(PG8_SA(0, 1), a2 + hstepA, voffA);
            PG8_WAIT_L(8); PG8_BAR; PG8_WAIT_L(0); PG8_MMA(0, 0, At, B0); PG8_BAR; PG8_SCHED;
            PG8_LDB(B1, 1, 1); PG8_STAGE(PG8_SB(1, 0), b3, voffB);
            PG8_BAR; PG8_WAIT_L(0); PG8_MMA(0, 1, At, B1); PG8_BAR;
            PG8_LDA(At, 1, 1); PG8_STAGE(PG8_SA(1, 0), a3, voffA);
            PG8_BAR; PG8_WAIT_L(0); PG8_MMA(1, 0, At, B0); PG8_BAR; PG8_SCHED;
            PG8_STAGE(PG8_SB(1, 1), b3 + hstepB, voffB);
            PG8_WAIT_V(6); PG8_BAR; PG8_MMA(1, 1, At, B1); PG8_BAR;
            }
        }
        if constexpr (ALIGN_EPI) { if (wr == 0) PG8_BAR; }
        if constexpr (!Epi::AFTER_DRAIN) { E(acc, cur, wr, wc, fr, fq); S.done(cur); }
        if (!has_next) break;
#pragma unroll
        for (int a = 0; a < 2; ++a)
#pragma unroll
            for (int b = 0; b < 2; ++b)
#pragma unroll
                for (int m = 0; m < 4; ++m)
#pragma unroll
                    for (int n = 0; n < 2; ++n) acc[a][b][m][n] = (f32x4){0.f, 0.f, 0.f, 0.f};
        cur = nxt; cA = nA; cB = nB; ++ui;
        if constexpr (ALIGN_EPI) { if (wr == 1) PG8_BAR; }
    }
    PG8_WAIT_V(0);
    if constexpr (!ALIGN_EPI) { if (wr == 0) PG8_BAR; }
    PG8_BAR;
    if constexpr (Epi::AFTER_DRAIN) { E.fused(acc, cur, wr, wc, fr, fq, lds, wid, lane); S.done(cur); }
#undef PG8_AOFF
#undef PG8_SA
#undef PG8_SB
#undef PG8_STAGE
#undef PG8_LDA
#undef PG8_LDB
#undef PG8_MMA
#undef PG8_WAIT_V
#undef PG8_WAIT_L
#undef PG8_BAR
#undef PG8_SCHED
}
}

constexpr size_t WT_EIN = 0, WT_UQ = 5767168, WT_UKV = 6160384, WT_EOUT = 6684672, WT_OIN = 8781824, WT_GATE = 12976128, WT_OOUT = 14024704,
                 WT_WQ = 16121856, WT_WKV = 20316160, WT_WO = 28704768, WT_FIN = 32899072, WT_FOUT = 55967744, WT_TOTAL = 67502080;
static_assert(WS_WT + WT_TOTAL <= WS_KVMEM, "weights fit");
struct TJob { const float* W; bf16_t* WT; const float* ks; int ldw, K, rows, mode, srcoff, first; };
constexpr int NJOBS = 32;
struct Args { const void* in[29]; float* out; unsigned char* ws; TJob jobs[NJOBS]; int nitems, flags, ph_lo, ph_hi, li, pad; };
enum { FL_GDNPREP = 1, FL_GDNREC = 2, FL_MLA = 4, FL_XATTN = 8 };

__device__ __forceinline__ int tr_src(int mode, int srcoff, int r) {
    if (mode == 0) return srcoff + r;
    if (mode == 1) {
        if (r < 2048) return r;
        if (r < 2560) return r + 8;
        if (r < 2624) { const int p = r - 2560, g = p >> 3, half = (p >> 2) & 1, jj = p & 3; return 2568 + half * 32 + 4 * g + jj; }
        if (r < 2632) return 2048 + (r - 2624);
        return -1; }
    if (mode == 2) { const int tile = r >> 8, w = r & 255; return (w < 128) ? tile * 128 + w : 2816 + tile * 128 + (w - 128); }
    { const int h = r / 192, j = r % 192; if (j < 128) return r; const int p = j - 128, g = p >> 3, half = (p >> 2) & 1, jj = p & 3; return h * 192 + 128 + half * 32 + 4 * g + jj; }
}
__device__ __forceinline__ void p0_tr_item(const float* W, bf16_t* WT, const float* ks, int ldw, int K, int rows, int mode, int srcoff, int item, LAS float* scr, int lane) {
    const int nrb = rows >> 5, kb = item / nrb, rb = item - kb * nrb, k0 = 64 * kb, r0 = 32 * rb;
    const int rl = lane & 31, src = tr_src(mode, srcoff, r0 + rl);
#pragma unroll 8
    for (int i = 0; i < 32; ++i) { const int kk = 2 * i + (lane >> 5); float v = 0.f; if (src >= 0) v = W[(size_t)(k0 + kk) * ldw + src]; if (ks) v *= ks[k0 + kk]; scr[kk * 33 + rl] = v; }
    LDS_WAIT(); asm volatile("" ::: "memory");
    const int c = lane & 7;
#pragma unroll
    for (int j = 0; j < 4; ++j) { const int n = (lane >> 3) + 8 * j; const LAS float* s = scr + (8 * c) * 33 + n;
        v4u o; o.x = pk2(s[0 * 33], s[1 * 33]); o.y = pk2(s[2 * 33], s[3 * 33]); o.z = pk2(s[4 * 33], s[5 * 33]); o.w = pk2(s[6 * 33], s[7 * 33]);
        *(GAS v4u*)(WT + (size_t)(r0 + n) * K + k0 + 8 * c) = o; }
    LDS_WAIT(); asm volatile("" ::: "memory");
}
__device__ __forceinline__ void rms_row_to_bf16(const float* xrow, const float* g, bf16_t* orow, int lane) {
    const float4* xr = (const float4*)xrow + lane; float4 v[4]; float s = 0.f;
#pragma unroll
    for (int j = 0; j < 4; ++j) { v[j] = xr[64 * j]; s += (v[j].x * v[j].x + v[j].y * v[j].y) + (v[j].z * v[j].z + v[j].w * v[j].w); }
    const float r = rsqrtf(wave_sum(s) * (1.f / D_) + EPS);
    v2u* o8 = (v2u*)orow + lane;
#pragma unroll
    for (int j = 0; j < 4; ++j) { const float4 gg = ((const float4*)g)[lane + 64 * j]; v2u w; w.x = pk2(v[j].x * r * gg.x, v[j].y * r * gg.y); w.y = pk2(v[j].z * r * gg.z, v[j].w * r * gg.w); o8[64 * j] = w; }
}
__device__ __forceinline__ void rowwise_row(const bf16_t* yrow, const float* xin, float* xout, const float* g1, const float* g2, bf16_t* hrow, int lane) {
    float yv[16]; float4 xv[4]; float s = 0.f;
#pragma unroll
    for (int j = 0; j < 4; ++j) { const v2u w = ((const v2u*)yrow)[lane + 64 * j];
        yv[4 * j] = __uint_as_float(w.x << 16); yv[4 * j + 1] = __uint_as_float(w.x & 0xffff0000u); yv[4 * j + 2] = __uint_as_float(w.y << 16); yv[4 * j + 3] = __uint_as_float(w.y & 0xffff0000u);
        s += (yv[4 * j] * yv[4 * j] + yv[4 * j + 1] * yv[4 * j + 1]) + (yv[4 * j + 2] * yv[4 * j + 2] + yv[4 * j + 3] * yv[4 * j + 3]); }
    const float r1 = rsqrtf(wave_sum(s) * (1.f / D_) + EPS); float s2 = 0.f;
#pragma unroll
    for (int j = 0; j < 4; ++j) { const float4 xi = ((const float4*)xin)[lane + 64 * j]; const float4 gg = ((const float4*)g1)[lane + 64 * j]; float4 xn;
        xn.x = xi.x + yv[4 * j] * r1 * gg.x; xn.y = xi.y + yv[4 * j + 1] * r1 * gg.y; xn.z = xi.z + yv[4 * j + 2] * r1 * gg.z; xn.w = xi.w + yv[4 * j + 3] * r1 * gg.w;
        xv[j] = xn; s2 += (xn.x * xn.x + xn.y * xn.y) + (xn.z * xn.z + xn.w * xn.w); ((float4*)xout)[lane + 64 * j] = xn; }
    if (hrow) { const float r2 = rsqrtf(wave_sum(s2) * (1.f / D_) + EPS);
#pragma unroll
        for (int j = 0; j < 4; ++j) { const float4 gg = ((const float4*)g2)[lane + 64 * j]; v2u w; w.x = pk2(xv[j].x * r2 * gg.x, xv[j].y * r2 * gg.y); w.y = pk2(xv[j].z * r2 * gg.z, xv[j].w * r2 * gg.w); ((v2u*)hrow)[lane + 64 * j] = w; } }
}
namespace pg8 {
typedef unsigned u32x2 __attribute__((ext_vector_type(2)));
#define EPI_ROWS_BEGIN(rvar) _Pragma("unroll") for (int ai = 0; ai < 2; ++ai) { _Pragma("unroll") for (int m = 0; m < 4; ++m) {
#define EPI_ROWS_END(rvar) rvar += 16; asm volatile("" : "+v"(rvar)); } rvar += 64; }
__device__ __forceinline__ void st8(bf16_t* p, f32x4 a, f32x4 b) { u32x4 w; w.x = cvt_pk_bf16(a[0], a[1]); w.y = cvt_pk_bf16(a[2], a[3]); w.z = cvt_pk_bf16(b[0], b[1]); w.w = cvt_pk_bf16(b[2], b[3]); *(u32x4*)p = w; }
__device__ __forceinline__ float fsig(float x) { return __builtin_amdgcn_rcpf(1.f + __expf(-x)); }
struct EpiPlain { static constexpr bool PERM = true, AFTER_DRAIN = false; bf16_t* O; int ldc, pad;
    __device__ __forceinline__ void operator()(const f32x4 (&acc)[2][2][4][2], const Unit& u, int wr, int wc, int fr, int fq) const {
        int row = u.pm * BM + wr * 64 + fr; const int col0 = u.pn * BM + wc * 32 + 8 * fq;
        EPI_ROWS_BEGIN(row) bf16_t* rowp = O + (size_t)row * ldc + col0;
#pragma unroll
            for (int bj = 0; bj < 2; ++bj) st8(rowp + bj * HALF, acc[ai][bj][m][0], acc[ai][bj][m][1]);
        EPI_ROWS_END(row)
    } };
struct EpiOin { static constexpr bool PERM = true, AFTER_DRAIN = false; bf16_t *xb, *gate;
    __device__ __forceinline__ void operator()(const f32x4 (&acc)[2][2][4][2], const Unit& u, int wr, int wc, int fr, int fq) const {
        const bool isg = u.pn >= 4; bf16_t* O = isg ? gate : xb;
        int row = u.pm * BM + wr * 64 + fr; const int col0 = (u.pn & 3) * BM + wc * 32 + 8 * fq;
        EPI_ROWS_BEGIN(row) bf16_t* rowp = O + (size_t)row * 1024 + col0;
#pragma unroll
            for (int bj = 0; bj < 2; ++bj) { f32x4 v0 = acc[ai][bj][m][0], v1 = acc[ai][bj][m][1];
                if (isg) {
#pragma unroll
                    for (int j = 0; j < 4; ++j) { const float a = v0[j], b = v1[j];
                        v0[j] = a * fsig(1.5957691216057308f * (a + 0.044715f * a * a * a)); v1[j] = b * fsig(1.5957691216057308f * (b + 0.044715f * b * b * b)); } }
                st8(rowp + bj * HALF, v0, v1); }
        EPI_ROWS_END(row)
    } };
struct EpiSwiglu { static constexpr bool PERM = true, AFTER_DRAIN = false; bf16_t* F;
    __device__ __forceinline__ void operator()(const f32x4 (&acc)[2][2][4][2], const Unit& u, int wr, int wc, int fr, int fq) const {
        int row = u.pm * BM + wr * 64 + fr; const int col0 = u.pn * HALF + wc * 32 + 8 * fq;
        EPI_ROWS_BEGIN(row) f32x4 o0, o1;
#pragma unroll
            for (int j = 0; j < 4; ++j) { const float g0 = acc[ai][0][m][0][j], g1 = acc[ai][0][m][1][j]; o0[j] = g0 * fsig(g0) * acc[ai][1][m][0][j]; o1[j] = g1 * fsig(g1) * acc[ai][1][m][1][j]; }
            st8(F + (size_t)row * DFF + col0, o0, o1);
        EPI_ROWS_END(row)
    } };
struct EpiLru { static constexpr bool PERM = true, AFTER_DRAIN = false; bf16_t *la, *uo; const bf16_t* xc; const float *ba, *bx, *ap;
    __device__ __forceinline__ void operator()(const f32x4 (&acc)[2][2][4][2], const Unit& u, int wr, int wc, int fr, int fq) const {
        const int colb = (u.pn >> 1) * 256 + (u.pn & 1) * HALF + wc * 32 + 8 * fq;
#pragma unroll
        for (int n = 0; n < 2; ++n) {
            const f32x4 cba = *(const f32x4*)(ba + colb + 4 * n), cbx = *(const f32x4*)(bx + colb + 4 * n), cap = *(const f32x4*)(ap + colb + 4 * n); f32x4 csp;
#pragma unroll
            for (int j = 0; j < 4; ++j) csp[j] = -8.f * (fmaxf(-cap[j], 0.f) + __logf(1.f + __expf(-fabsf(cap[j]))));
            int row = u.pm * BM + wr * 64 + fr;
            EPI_ROWS_BEGIN(row) const size_t off = (size_t)row * 1024 + colb + 4 * n;
                const u32x2 xw = *(const u32x2*)(xc + off); f32x4 xv;
                xv[0] = __uint_as_float(xw.x << 16); xv[1] = __uint_as_float(xw.x & 0xffff0000u); xv[2] = __uint_as_float(xw.y << 16); xv[3] = __uint_as_float(xw.y & 0xffff0000u);
                f32x4 l, uu;
#pragma unroll
                for (int j = 0; j < 4; ++j) { const float r = fsig(acc[ai][0][m][n][j] + cba[j]), ii = fsig(acc[ai][1][m][n][j] + cbx[j]); l[j] = r * csp[j]; uu[j] = sqrtf(fmaxf(1.f - __expf(2.f * l[j]), 0.f)) * ii * xv[j]; }
                u32x2 wl, wu; wl.x = cvt_pk_bf16(l[0], l[1]); wl.y = cvt_pk_bf16(l[2], l[3]); wu.x = cvt_pk_bf16(uu[0], uu[1]); wu.y = cvt_pk_bf16(uu[2], uu[3]);
                *(u32x2*)(la + off) = wl; *(u32x2*)(uo + off) = wu;
            EPI_ROWS_END(row)
        }
    } };
struct EpiUq { static constexpr bool PERM = true, AFTER_DRAIN = false; bf16_t* q; const float *ssq, *ct, *st;
    __device__ __forceinline__ void operator()(const f32x4 (&acc)[2][2][4][2], const Unit& u, int wr, int wc, int fr, int fq) const {
        int row = u.pm * BM + wr * 64 + fr;
        EPI_ROWS_BEGIN(row) const f32x4 sp = *(const f32x4*)(ssq + (size_t)row * 8);
            const float rs = rsqrtf(((sp[0] + sp[1]) + (sp[2] + sp[3])) * (1.f / 256.f) + EPS);
#pragma unroll
            for (int bj = 0; bj < 2; ++bj) { const int c0 = u.pn * BM + bj * HALF + wc * 32 + 8 * fq, h = c0 / 192, j0 = c0 - h * 192;
                f32x4 v0 = acc[ai][bj][m][0] * rs, v1 = acc[ai][bj][m][1] * rs;
                if (j0 >= 128) { const int g = (j0 - 128) >> 3; const f32x4 c = *(const f32x4*)(ct + (size_t)row * 32 + 4 * g), s = *(const f32x4*)(st + (size_t)row * 32 + 4 * g);
                    const f32x4 o1 = v0 * c - v1 * s, o2 = v0 * s + v1 * c; v0 = o1; v1 = o2; }
                st8(q + (size_t)row * 768 + c0, v0, v1); }
        EPI_ROWS_END(row)
    } };
struct EpiUkv { static constexpr bool PERM = true, AFTER_DRAIN = false; bf16_t *knope, *vmla; const float* ssq;
    __device__ __forceinline__ void operator()(const f32x4 (&acc)[2][2][4][2], const Unit& u, int wr, int wc, int fr, int fq) const {
        int row = u.pm * BM + wr * 64 + fr; const int col0 = u.pn * 128 + wc * 32 + 8 * fq;
        EPI_ROWS_BEGIN(row) const f32x4 sp = *(const f32x4*)(ssq + (size_t)row * 8 + 4);
            const float rs = rsqrtf(((sp[0] + sp[1]) + (sp[2] + sp[3])) * (1.f / 256.f) + EPS);
            st8(knope + (size_t)row * 512 + col0, acc[ai][0][m][0] * rs, acc[ai][0][m][1] * rs);
            st8(vmla + (size_t)row * 512 + col0, acc[ai][1][m][0] * rs, acc[ai][1][m][1] * rs);
        EPI_ROWS_END(row)
    } };
struct EpiEin { static constexpr bool PERM = true, AFTER_DRAIN = false; unsigned char* ws;
    __device__ __forceinline__ void operator()(const f32x4 (&acc)[2][2][4][2], const Unit& u, int wr, int wc, int fr, int fq) const {
        int row = u.pm * BM + wr * 64 + fr; const int pn = u.pn;
        if (pn < 10) {
            bf16_t* O; int ld, cb;
            if (pn < 4) { O = (bf16_t*)(ws + WS_QK); ld = 1024; cb = pn * 256; } else if (pn < 6) { O = (bf16_t*)(ws + WS_Y); ld = 512; cb = (pn - 4) * 256; }
            else if (pn < 8) { O = (bf16_t*)(ws + WS_Z); ld = 512; cb = (pn - 6) * 256; } else { O = (bf16_t*)(ws + WS_Y + 16 * MiB); ld = 512; cb = (pn - 8) * 256; }
            float* ssq = (float*)(ws + WS_SSQ);
            const int col0 = cb + wc * 32 + 8 * fq;
            EPI_ROWS_BEGIN(row) bf16_t* rowp = O + (size_t)row * ld + col0; float s = 0.f;
#pragma unroll
                for (int bj = 0; bj < 2; ++bj) { const f32x4 a = acc[ai][bj][m][0], b = acc[ai][bj][m][1]; st8(rowp + bj * HALF, a, b);
                    s += (a[0] * a[0] + a[1] * a[1]) + (a[2] * a[2] + a[3] * a[3]) + (b[0] * b[0] + b[1] * b[1]) + (b[2] * b[2] + b[3] * b[3]); }
                if (pn >= 8) { s += __shfl_xor(s, 16); s += __shfl_xor(s, 32); if (fq == 0) ssq[(size_t)row * 8 + (pn - 8) * 4 + wc] = s; }
            EPI_ROWS_END(row)
        } else {
            const float* ct = (const float*)(ws + WS_ROPEC); const float* st = (const float*)(ws + WS_ROPES); bf16_t* kpe = (bf16_t*)(ws + WS_KPE); float* ab = (float*)(ws + WS_ABUF);
            EPI_ROWS_BEGIN(row)
                if (wc < 2) { const int g = 4 * wc + fq; const f32x4 c = *(const f32x4*)(ct + (size_t)row * 32 + 4 * g), s = *(const f32x4*)(st + (size_t)row * 32 + 4 * g);
                    const f32x4 x1 = acc[ai][0][m][0], x2 = acc[ai][0][m][1]; st8(kpe + (size_t)row * 64 + 8 * g, x1 * c - x2 * s, x1 * s + x2 * c); }
                else if (wc == 2 && fq == 0) { *(f32x4*)(ab + (size_t)row * 8) = acc[ai][0][m][0]; *(f32x4*)(ab + (size_t)row * 8 + 4) = acc[ai][0][m][1]; }
            EPI_ROWS_END(row)
        }
    } };
#undef EPI_ROWS_BEGIN
#undef EPI_ROWS_END
}
namespace attn {
typedef short bf16x8 __attribute__((ext_vector_type(8)));
typedef short s16x4 __attribute__((ext_vector_type(4)));
typedef float f32x16 __attribute__((ext_vector_type(16)));
typedef unsigned u32x4 __attribute__((ext_vector_type(4)));
typedef unsigned u32x2 __attribute__((ext_vector_type(2)));
__device__ __forceinline__ unsigned cvtpk(float lo, float hi) { unsigned r; asm volatile("v_cvt_pk_bf16_f32 %0, %1, %2" : "=v"(r) : "v"(lo), "v"(hi)); return r; }
__device__ __forceinline__ s16x4 vtr(const LAS unsigned char* p) { return __builtin_bit_cast(s16x4, __builtin_amdgcn_ds_read_tr16_b64_v4i16((LAS s16x4*)p)); }

template <int DQK, int DV, int KT, int NQG, int NDS>
struct Body {
    static constexpr int DVW = DV / NDS, NH = KT / 32, KCH = DQK / 8, VCH = DV / 8;
    static constexpr int K_PITCH = DQK * 2 + 16, V_PITCH = DV * 2 + 64;
    static constexpr int KBYTES = KT * K_PITCH, VBYTES = KT * V_PITCH, BUF = KBYTES + VBYTES;
    static constexpr int KPT = KT * KCH / 512, VPT = KT * VCH / 512;
    static_assert(NQG * NDS == 8 && KT * KCH % 512 == 0 && KT * VCH % 512 == 0 && 2 * BUF <= RING_BYTES, "attention geometry");
    __device__ static __forceinline__ void unit(LAS unsigned char* lds, const bf16_t* Qp, int ldq, const bf16_t* K1, int ldk1, int d1, const bf16_t* K2, int ldk2,
                                                const bf16_t* Vp, int ldv, bf16_t* Op, int ldo, int ntiles, int causal_q0, float sc2) {
        const int tid = threadIdx.x, l = tid & 63, r32 = l & 31, hi = l >> 5, w = __builtin_amdgcn_readfirstlane(tid >> 6), qg = w % NQG, ds = w / NQG;
        const int nt_w = causal_q0 >= 0 ? ((causal_q0 + 32 * qg) / KT + 1) : ntiles;
        bf16x8 qf[DQK / 16];
#pragma unroll
        for (int s = 0; s < DQK / 16; ++s) qf[s] = *(const bf16x8*)(Qp + (size_t)(32 * qg + r32) * ldq + 16 * s + 8 * hi);
        f32x16 o[DVW / 32];
#pragma unroll
        for (int i = 0; i < DVW / 32; ++i)
#pragma unroll
            for (int r = 0; r < 16; ++r) o[i][r] = 0.f;
        float mrun = -1e30f, lsum = 0.f;
        v4u kreg[KPT], vreg[VPT];
#define ATT_LOAD(t) do { int tl_ = threadIdx.x; asm volatile("" : "+v"(tl_)); \
            _Pragma("unroll") for (int i = 0; i < KPT; ++i) { const int idx = tl_ + 512 * i, row = idx / KCH, c = idx - row * KCH; \
                const bf16_t* src = (c * 8 < d1) ? K1 + (size_t)((t) * KT + row) * ldk1 + c * 8 : K2 + (size_t)((t) * KT + row) * ldk2 + (c * 8 - d1); kreg[i] = *(const v4u*)src; } \
            _Pragma("unroll") for (int i = 0; i < VPT; ++i) { const int idx = tl_ + 512 * i, row = idx / VCH, c = idx - row * VCH; vreg[i] = *(const v4u*)(Vp + (size_t)((t) * KT + row) * ldv + c * 8); } } while (0)
#define ATT_STORE(b) do { int tl_ = threadIdx.x; asm volatile("" : "+v"(tl_)); \
            _Pragma("unroll") for (int i = 0; i < KPT; ++i) { const int idx = tl_ + 512 * i, row = idx / KCH, c = idx - row * KCH; *(LAS v4u*)(lds + (b) * BUF + row * K_PITCH + c * 16) = kreg[i]; } \
            _Pragma("unroll") for (int i = 0; i < VPT; ++i) { const int idx = tl_ + 512 * i, row = idx / VCH, c = idx - row * VCH; *(LAS v4u*)(lds + (b) * BUF + KBYTES + row * V_PITCH + c * 16) = vreg[i]; } } while (0)
        ATT_LOAD(0); ATT_STORE(0);
        __syncthreads();
        for (int t = 0; t < ntiles; ++t) {
            const int b = t & 1;
            if (t + 1 < ntiles) ATT_LOAD(t + 1);
            if (t < nt_w) {
                const LAS unsigned char* kb = lds + b * BUF + r32 * K_PITCH + hi * 16;
                f32x16 p[NH];
#pragma unroll
                for (int hf = 0; hf < NH; ++hf)
#pragma unroll
                    for (int r = 0; r < 16; ++r) p[hf][r] = 0.f;
#pragma unroll
                for (int s = 0; s < DQK / 16; ++s)
#pragma unroll
                    for (int hf = 0; hf < NH; ++hf) { const bf16x8 a = *(const LAS bf16x8*)(kb + hf * 32 * K_PITCH + s * 32); p[hf] = __builtin_amdgcn_mfma_f32_32x32x16_bf16(a, qf[s], p[hf], 0, 0, 0);
                        if (hf == NH - 1 && (s % 2) == 1) __builtin_amdgcn_sched_barrier(0); }
                float mx = p[0][0];
#pragma unroll
                for (int hf = 0; hf < NH; ++hf)
#pragma unroll
                    for (int r = 0; r < 16; ++r) mx = fmaxf(mx, p[hf][r]);
                mx = fmaxf(mx, __shfl_xor(mx, 32));
                const float mnew = fmaxf(mrun, mx), alpha = __builtin_amdgcn_exp2f((mrun - mnew) * sc2), mc = mnew * sc2; mrun = mnew;
                float ps = 0.f;
#pragma unroll
                for (int hf = 0; hf < NH; ++hf)
#pragma unroll
                    for (int r = 0; r < 16; ++r) { const float e = __builtin_amdgcn_exp2f(p[hf][r] * sc2 - mc); p[hf][r] = e; ps += e; }
                lsum = lsum * alpha + ps;
#pragma unroll
                for (int i = 0; i < DVW / 32; ++i)
#pragma unroll
                    for (int r = 0; r < 16; ++r) o[i][r] *= alpha;
                bf16x8 pf[NH * 2];
#pragma unroll
                for (int hf = 0; hf < NH; ++hf)
#pragma unroll
                    for (int s2 = 0; s2 < 2; ++s2) { u32x4 pw; pw.x = cvtpk(p[hf][8 * s2], p[hf][8 * s2 + 1]); pw.y = cvtpk(p[hf][8 * s2 + 2], p[hf][8 * s2 + 3]); pw.z = cvtpk(p[hf][8 * s2 + 4], p[hf][8 * s2 + 5]); pw.w = cvtpk(p[hf][8 * s2 + 6], p[hf][8 * s2 + 7]);
                        pf[hf * 2 + s2] = __builtin_bit_cast(bf16x8, pw); }
                const LAS unsigned char* vb = lds + b * BUF + KBYTES + (4 * hi + ((l & 15) >> 2)) * V_PITCH + (ds * DVW + 16 * ((l >> 4) & 1) + 4 * (l & 3)) * 2;
#pragma unroll
                for (int dvb = 0; dvb < DVW / 32; ++dvb)
#pragma unroll
                    for (int ks = 0; ks < KT / 16; ++ks) { const s16x4 lo = vtr(vb + ks * 16 * V_PITCH + dvb * 64), hh = vtr(vb + (ks * 16 + 8) * V_PITCH + dvb * 64);
                        const bf16x8 a = (bf16x8){lo[0], lo[1], lo[2], lo[3], hh[0], hh[1], hh[2], hh[3]};
                        o[dvb] = __builtin_amdgcn_mfma_f32_32x32x16_bf16(a, pf[ks], o[dvb], 0, 0, 0);
                        if (ks == KT / 16 - 1) __builtin_amdgcn_sched_barrier(0); }
            }
            if (t + 1 < ntiles) ATT_STORE(b ^ 1);
            __syncthreads();
        }
#undef ATT_LOAD
#undef ATT_STORE
        lsum += __shfl_xor(lsum, 32);
        const float inv = __builtin_amdgcn_rcpf(lsum);
        bf16_t* orow = Op + (size_t)(32 * qg + r32) * ldo + ds * DVW + 4 * hi;
#pragma unroll
        for (int dvb = 0; dvb < DVW / 32; ++dvb)
#pragma unroll
            for (int g4 = 0; g4 < 4; ++g4) { u32x2 wv; wv.x = cvtpk(o[dvb][4 * g4] * inv, o[dvb][4 * g4 + 1] * inv); wv.y = cvtpk(o[dvb][4 * g4 + 2] * inv, o[dvb][4 * g4 + 3] * inv);
                *(u32x2*)(orow + 32 * dvb + 8 * g4) = wv; }
    }
};
typedef Body<192, 128, 64, 8, 1> Mla;
typedef Body<256, 256, 32, 4, 2> Xat;
}

namespace gdn {
using attn::bf16x8; using attn::s16x4; using attn::f32x16; using attn::u32x4; using attn::u32x2; using attn::cvtpk; using attn::vtr;
constexpr int QP = 272, LP = 272, TP = 144;
constexpr int P_QS = 0, P_KS = 17408, P_VS = 34816, P_LS = 52224, P_TU = 69632, P_TW = 78848, P_GC = 88064, P_BT = 88320, P_EG = 88576, P_END = 88832;
__device__ __forceinline__ void unpack8(const v4u w, float* f) {
    f[0] = __uint_as_float(w.x << 16); f[1] = __uint_as_float(w.x & 0xffff0000u); f[2] = __uint_as_float(w.y << 16); f[3] = __uint_as_float(w.y & 0xffff0000u);
    f[4] = __uint_as_float(w.z << 16); f[5] = __uint_as_float(w.z & 0xffff0000u); f[6] = __uint_as_float(w.w << 16); f[7] = __uint_as_float(w.w & 0xffff0000u); }
__device__ __forceinline__ void conv16(const bf16_t* src, int ld, size_t rowb, int tcur, const float* cw, float* acc) {
#pragma unroll
    for (int e = 0; e < 16; ++e) acc[e] = 0.f;
#pragma unroll
    for (int j = 0; j < 4; ++j) { if (tcur - 3 + j < 0) continue;
        const bf16_t* p = src + (rowb - 3 + j) * ld; const v4u w0 = *(const v4u*)p, w1 = *(const v4u*)(p + 8); float xv[16]; unpack8(w0, xv); unpack8(w1, xv + 8);
#pragma unroll
        for (int q4 = 0; q4 < 4; ++q4) { const float4 wv = *(const float4*)(cw + j * 1536 + 4 * q4); acc[4 * q4] += wv.x * xv[4 * q4]; acc[4 * q4 + 1] += wv.y * xv[4 * q4 + 1]; acc[4 * q4 + 2] += wv.z * xv[4 * q4 + 2]; acc[4 * q4 + 3] += wv.w * xv[4 * q4 + 3]; } }
#pragma unroll
    for (int e = 0; e < 16; ++e) acc[e] = acc[e] * __builtin_amdgcn_rcpf(1.f + __expf(-acc[e]));
}
__device__ __forceinline__ void pack16(const float* a, float s, v4u& o0, v4u& o1) {
    o0.x = pk2(a[0] * s, a[1] * s); o0.y = pk2(a[2] * s, a[3] * s); o0.z = pk2(a[4] * s, a[5] * s); o0.w = pk2(a[6] * s, a[7] * s);
    o1.x = pk2(a[8] * s, a[9] * s); o1.y = pk2(a[10] * s, a[11] * s); o1.z = pk2(a[12] * s, a[13] * s); o1.w = pk2(a[14] * s, a[15] * s); }

__device__ __forceinline__ void prep_chunk(LAS unsigned char* lds, int chunk, const bf16_t* qk, const bf16_t* vb, const float* ab, const float* convw, const float* a_log, const float* dt_bias,
                                           bf16_t* qh, bf16_t* kT, bf16_t* wout, bf16_t* uT, bf16_t* aqk, float* egc, float* edec, float* egl) {
    const int tid = threadIdx.x, l = tid & 63, r32 = l & 31, hi = l >> 5, w = __builtin_amdgcn_readfirstlane(tid >> 6);
    const int b = chunk >> 7, h = (chunk >> 5) & 3, n = chunk & 31, t0 = n * 64; const size_t row0 = (size_t)b * T_ + t0;
    LAS float* gcs = (LAS float*)(lds + P_GC); LAS float* bts = (LAS float*)(lds + P_BT); LAS float* egs = (LAS float*)(lds + P_EG);
    if (w == 0) {
        const float a = ab[(row0 + l) * 8 + h], bb = ab[(row0 + l) * 8 + 4 + h];
        float s = -__expf(a_log[h]) * softplusf_(a + dt_bias[h]);
#pragma unroll
        for (int o = 1; o < 64; o <<= 1) { const float t = __shfl_up(s, o); if (l >= o) s += t; }
        const float glast = __shfl(s, 63), eg = __expf(s);
        gcs[l] = s; bts[l] = sigmoidf_(bb); egs[l] = eg;
        egc[(size_t)(b * 4 + h) * T_ + t0 + l] = eg; edec[(size_t)(b * 4 + h) * T_ + t0 + l] = __expf(glast - s); if (l == 0) egl[chunk] = __expf(glast);
    }
    {
        const int c = tid >> 3, ch0 = (tid & 7) * 16; const size_t rowb = row0 + c; const int tcur = t0 + c; float acc[16]; v4u o0, o1;
        conv16(qk + h * 128 + ch0, 1024, rowb, tcur, convw + h * 128 + ch0, acc);
        { float ss = 0.f;
#pragma unroll
          for (int e = 0; e < 16; ++e) ss += acc[e] * acc[e];
          ss += __shfl_xor(ss, 1); ss += __shfl_xor(ss, 2); ss += __shfl_xor(ss, 4);
          pack16(acc, rsqrtf(ss + EPS) * 0.08838834764831845f, o0, o1);
          *(LAS v4u*)(lds + P_QS + c * QP + ch0 * 2) = o0; *(LAS v4u*)(lds + P_QS + c * QP + ch0 * 2 + 16) = o1;
          *(v4u*)(qh + rowb * 512 + h * 128 + ch0) = o0; *(v4u*)(qh + rowb * 512 + h * 128 + ch0 + 8) = o1; }
        conv16(qk + 512 + h * 128 + ch0, 1024, rowb, tcur, convw + 512 + h * 128 + ch0, acc);
        { float ss = 0.f;
#pragma unroll
          for (int e = 0; e < 16; ++e) ss += acc[e] * acc[e];
          ss += __shfl_xor(ss, 1); ss += __shfl_xor(ss, 2); ss += __shfl_xor(ss, 4);
          pack16(acc, rsqrtf(ss + EPS), o0, o1);
          *(LAS v4u*)(lds + P_KS + c * QP + ch0 * 2) = o0; *(LAS v4u*)(lds + P_KS + c * QP + ch0 * 2 + 16) = o1; }
        conv16(vb + h * 128 + ch0, 512, rowb, tcur, convw + 1024 + h * 128 + ch0, acc);
        pack16(acc, 1.f, o0, o1);
        *(LAS v4u*)(lds + P_VS + c * QP + ch0 * 2) = o0; *(LAS v4u*)(lds + P_VS + c * QP + ch0 * 2 + 16) = o1;
    }
    __syncthreads();
    {
        const int dk = tid >> 2, c0 = (tid & 3) * 16; unsigned wv[8];
#pragma unroll
        for (int i = 0; i < 8; ++i) { const unsigned lo = *(const LAS bf16_t*)(lds + P_KS + (c0 + 2 * i) * QP + dk * 2), hi2 = *(const LAS bf16_t*)(lds + P_KS + (c0 + 2 * i + 1) * QP + dk * 2); wv[i] = lo | (hi2 << 16); }
        bf16_t* dst = kT + ((size_t)chunk * 128 + dk) * 64 + c0;
        *(v4u*)dst = (v4u){wv[0], wv[1], wv[2], wv[3]}; *(v4u*)(dst + 8) = (v4u){wv[4], wv[5], wv[6], wv[7]};
    }
    {
        const int mat = w >> 2, rbk = (w >> 1) & 1, cbk = w & 1;
        if (!(rbk == 0 && cbk == 1)) {
            const LAS unsigned char* ap = lds + (mat ? P_QS : P_KS) + (32 * rbk + r32) * QP + hi * 16; const LAS unsigned char* bp = lds + P_KS + (32 * cbk + r32) * QP + hi * 16;
            f32x16 acc;
#pragma unroll
            for (int r = 0; r < 16; ++r) acc[r] = 0.f;
#pragma unroll
            for (int st = 0; st < 8; ++st) { const bf16x8 a = *(const LAS bf16x8*)(ap + st * 32), bb = *(const LAS bf16x8*)(bp + st * 32); acc = __builtin_amdgcn_mfma_f32_32x32x16_bf16(a, bb, acc, 0, 0, 0); }
            const int s = 32 * cbk + r32; const float gs = gcs[s];
#pragma unroll
            for (int r = 0; r < 16; ++r) { const int c = 32 * rbk + (r & 3) + 8 * (r >> 2) + 4 * hi; const float dec = (s <= c) ? __expf(gcs[c] - gs) : 0.f;
                if (mat == 0) *(LAS float*)(lds + P_LS + c * LP + s * 4) = (s < c) ? bts[c] * acc[r] * dec : 0.f;
                else aqk[(size_t)chunk * 4096 + c * 64 + s] = f2bf(acc[r] * dec); }
        } else if (mat == 1) {
#pragma unroll
            for (int r = 0; r < 16; ++r) { const int c = (r & 3) + 8 * (r >> 2) + 4 * hi; aqk[(size_t)chunk * 4096 + c * 64 + 32 + r32] = 0; }
        }
    }
    __syncthreads();
    if (w == 0) {
        float tc[64];
#pragma unroll
        for (int c = 0; c < 64; ++c) { float a0 = (c == l) ? 1.f : 0.f, a1 = 0.f, a2 = 0.f, a3 = 0.f;
#pragma unroll
            for (int s4 = 0; s4 < (c + 3) / 4; ++s4) { const pg8::f32x4 lv = *(const LAS pg8::f32x4*)(lds + P_LS + c * LP + s4 * 16);
                if (4 * s4 < c) a0 -= lv.x * tc[4 * s4]; if (4 * s4 + 1 < c) a1 -= lv.y * tc[4 * s4 + 1]; if (4 * s4 + 2 < c) a2 -= lv.z * tc[4 * s4 + 2]; if (4 * s4 + 3 < c) a3 -= lv.w * tc[4 * s4 + 3]; }
            tc[c] = (a0 + a1) + (a2 + a3); }
        const float bj = bts[l], bej = bj * egs[l];
#pragma unroll
        for (int c = 0; c < 64; ++c) { *(LAS bf16_t*)(lds + P_TU + c * TP + l * 2) = f2bf(tc[c] * bj); *(LAS bf16_t*)(lds + P_TW + c * TP + l * 2) = f2bf(tc[c] * bej); }
    }
    __syncthreads();
    {
        const int mat = w >> 2, dblk = w & 3;
        const LAS unsigned char* tp = lds + (mat ? P_TW : P_TU) + r32 * TP + hi * 16;
        const LAS unsigned char* xp = lds + (mat ? P_KS : P_VS) + (8 * hi + ((l & 15) >> 2)) * QP + (32 * dblk + 16 * ((l >> 4) & 1) + 4 * (l & 3)) * 2;
        f32x16 acc[2];
#pragma unroll
        for (int cb = 0; cb < 2; ++cb)
#pragma unroll
            for (int r = 0; r < 16; ++r) acc[cb][r] = 0.f;
#pragma unroll
        for (int st = 0; st < 4; ++st) { const s16x4 lo = vtr(xp + st * 16 * QP), hh = vtr(xp + (st * 16 + 4) * QP);
            const bf16x8 bb = (bf16x8){lo[0], lo[1], lo[2], lo[3], hh[0], hh[1], hh[2], hh[3]};
#pragma unroll
            for (int cb = 0; cb < 2; ++cb) { const bf16x8 a = *(const LAS bf16x8*)(tp + cb * 32 * TP + st * 32); acc[cb] = __builtin_amdgcn_mfma_f32_32x32x16_bf16(a, bb, acc[cb], 0, 0, 0); } }
        if (mat == 0) { bf16_t* dst = uT + ((size_t)chunk * 128 + 32 * dblk + r32) * 64 + 4 * hi;
#pragma unroll
            for (int cb = 0; cb < 2; ++cb)
#pragma unroll
                for (int g4 = 0; g4 < 4; ++g4) { u32x2 wv; wv.x = cvtpk(acc[cb][4 * g4], acc[cb][4 * g4 + 1]); wv.y = cvtpk(acc[cb][4 * g4 + 2], acc[cb][4 * g4 + 3]); *(u32x2*)(dst + 32 * cb + 8 * g4) = wv; }
        } else {
#pragma unroll
            for (int cb = 0; cb < 2; ++cb)
#pragma unroll
                for (int r = 0; r < 16; ++r) { const int c = 32 * cb + (r & 3) + 8 * (r >> 2) + 4 * hi; wout[(row0 + c) * 512 + h * 128 + 32 * dblk + r32] = f2bf(acc[cb][r]); }
        }
    }
    __syncthreads();
}

constexpr int WP = 264, KP = 136;
constexpr int R_WS = 0, R_QS = 16896, R_KT = 33792, R_AQ = 51200, R_EG = 59904, R_ED = 60160, R_BUF = 60416;
static_assert(2 * R_BUF <= RING_BYTES && P_END <= RING_BYTES, "GDN LDS maps");
__device__ __forceinline__ bf16x8 afrag(const LAS unsigned char* p) { const u32x2 a = *(const LAS u32x2*)p, b = *(const LAS u32x2*)(p + 16); return __builtin_bit_cast(bf16x8, (u32x4){a.x, a.y, b.x, b.y}); }
__device__ __forceinline__ bf16x8 packb(const f32x16& v, int s2) { u32x4 pw; pw.x = cvtpk(v[8 * s2], v[8 * s2 + 1]); pw.y = cvtpk(v[8 * s2 + 2], v[8 * s2 + 3]); pw.z = cvtpk(v[8 * s2 + 4], v[8 * s2 + 5]); pw.w = cvtpk(v[8 * s2 + 6], v[8 * s2 + 7]); return __builtin_bit_cast(bf16x8, pw); }
__device__ __forceinline__ void rec_unit(LAS unsigned char* lds, int bh, const bf16_t* qh, const bf16_t* kT, const bf16_t* wb, const bf16_t* uT, const bf16_t* aqk,
                                         const float* egc, const float* edec, const float* egl, float* obuf) {
    const int tid = threadIdx.x, l = tid & 63, r32 = l & 31, hi = l >> 5, w = __builtin_amdgcn_readfirstlane(tid >> 6);
    const int b = bh >> 2, h = bh & 3;
    f32x16 S[4];
#pragma unroll
    for (int rb = 0; rb < 4; ++rb)
#pragma unroll
        for (int r = 0; r < 16; ++r) S[rb][r] = 0.f;
    v4u tw[2], tq[2], tk[2], ta, te; u32x2 ur[8];
#define REC_LOAD(n_) do { int tl_ = threadIdx.x; asm volatile("" : "+v"(tl_)); const int chunk_ = bh * 32 + (n_); const size_t rw_ = (size_t)b * T_ + (n_) * 64; \
        _Pragma("unroll") for (int i = 0; i < 2; ++i) { const int idx = tl_ + 512 * i, row = idx >> 4, c = idx & 15; tw[i] = *(const v4u*)(wb + (rw_ + row) * 512 + h * 128 + c * 8); tq[i] = *(const v4u*)(qh + (rw_ + row) * 512 + h * 128 + c * 8); } \
        _Pragma("unroll") for (int i = 0; i < 2; ++i) { const int idx = tl_ + 512 * i; tk[i] = *(const v4u*)(kT + (size_t)chunk_ * 8192 + idx * 8); } \
        ta = *(const v4u*)(aqk + (size_t)chunk_ * 4096 + tl_ * 8); \
        if (tl_ < 32) te = *(const v4u*)((tl_ < 16 ? egc : edec) + (size_t)bh * T_ + (n_) * 64 + (tl_ & 15) * 4); \
        if (tl_ < 256) { _Pragma("unroll") for (int cb = 0; cb < 2; ++cb) _Pragma("unroll") for (int g4 = 0; g4 < 4; ++g4) \
            ur[cb * 4 + g4] = *(const u32x2*)(uT + ((size_t)chunk_ * 128 + 32 * (tl_ >> 6) + (tl_ & 31)) * 64 + 32 * cb + 8 * g4 + 4 * ((tl_ >> 5) & 1)); } } while (0)
#define REC_ST16(off_, v_) do { *(LAS u32x2*)(lds + (off_)) = (u32x2){(v_).x, (v_).y}; *(LAS u32x2*)(lds + (off_) + 8) = (u32x2){(v_).z, (v_).w}; } while (0)
#define REC_STORE(bf_) do { int tl_ = threadIdx.x; asm volatile("" : "+v"(tl_)); \
        _Pragma("unroll") for (int i = 0; i < 2; ++i) { const int idx = tl_ + 512 * i, row = idx >> 4, c = idx & 15; REC_ST16((bf_) * R_BUF + R_WS + row * WP + c * 16, tw[i]); REC_ST16((bf_) * R_BUF + R_QS + row * WP + c * 16, tq[i]); } \
        _Pragma("unroll") for (int i = 0; i < 2; ++i) { const int idx = tl_ + 512 * i, row = idx >> 3, c = idx & 7; REC_ST16((bf_) * R_BUF + R_KT + row * KP + c * 16, tk[i]); } \
        { const int row = tl_ >> 3, c = tl_ & 7; REC_ST16((bf_) * R_BUF + R_AQ + row * KP + c * 16, ta); } \
        if (tl_ < 32) *(LAS v4u*)(lds + (bf_) * R_BUF + (tl_ < 16 ? R_EG : R_ED) + (tl_ & 15) * 16) = te; } while (0)
    REC_LOAD(0); REC_STORE(0);
    u32x2 uc[8];
#pragma unroll
    for (int i = 0; i < 8; ++i) uc[i] = ur[i];
    __syncthreads();
    for (int n = 0; n < 32; ++n) {
        const int bf = n & 1;
        if (n + 1 < 32) REC_LOAD(n + 1);
        if (w < 4) {
            const LAS unsigned char* base = lds + bf * R_BUF;
            const LAS unsigned char* wrow = base + R_WS + r32 * WP + hi * 8; const LAS unsigned char* qrow = base + R_QS + r32 * WP + hi * 8;
            f32x16 aw[2], aq[2];
#pragma unroll
            for (int cb = 0; cb < 2; ++cb)
#pragma unroll
                for (int r = 0; r < 16; ++r) { aw[cb][r] = 0.f; aq[cb][r] = 0.f; }
#pragma unroll
            for (int rb = 0; rb < 4; ++rb)
#pragma unroll
                for (int s2 = 0; s2 < 2; ++s2) { const bf16x8 sb = packb(S[rb], s2); const int ko = (32 * rb + 16 * s2) * 2;
#pragma unroll
                    for (int cb = 0; cb < 2; ++cb) { aw[cb] = __builtin_amdgcn_mfma_f32_32x32x16_bf16(afrag(wrow + cb * 32 * WP + ko), sb, aw[cb], 0, 0, 0);
                                                     aq[cb] = __builtin_amdgcn_mfma_f32_32x32x16_bf16(afrag(qrow + cb * 32 * WP + ko), sb, aq[cb], 0, 0, 0); } }
            bf16x8 vbf[2][2], vdf[2][2];
#pragma unroll
            for (int cb = 0; cb < 2; ++cb) {
#pragma unroll
                for (int g4 = 0; g4 < 4; ++g4) { const u32x2 uw = uc[cb * 4 + g4]; const pg8::f32x4 eg = *(const LAS pg8::f32x4*)(base + R_EG + (32 * cb + 8 * g4 + 4 * hi) * 4);
                    aw[cb][4 * g4] = __uint_as_float(uw.x << 16) - aw[cb][4 * g4]; aw[cb][4 * g4 + 1] = __uint_as_float(uw.x & 0xffff0000u) - aw[cb][4 * g4 + 1];
                    aw[cb][4 * g4 + 2] = __uint_as_float(uw.y << 16) - aw[cb][4 * g4 + 2]; aw[cb][4 * g4 + 3] = __uint_as_float(uw.y & 0xffff0000u) - aw[cb][4 * g4 + 3];
                    aq[cb][4 * g4] *= eg.x; aq[cb][4 * g4 + 1] *= eg.y; aq[cb][4 * g4 + 2] *= eg.z; aq[cb][4 * g4 + 3] *= eg.w;
                }
                vbf[cb][0] = packb(aw[cb], 0); vbf[cb][1] = packb(aw[cb], 1);
                f32x16 vd;
#pragma unroll
                for (int g4 = 0; g4 < 4; ++g4) { const pg8::f32x4 ed = *(const LAS pg8::f32x4*)(base + R_ED + (32 * cb + 8 * g4 + 4 * hi) * 4);
                    vd[4 * g4] = aw[cb][4 * g4] * ed.x; vd[4 * g4 + 1] = aw[cb][4 * g4 + 1] * ed.y; vd[4 * g4 + 2] = aw[cb][4 * g4 + 2] * ed.z; vd[4 * g4 + 3] = aw[cb][4 * g4 + 3] * ed.w; }
                vdf[cb][0] = packb(vd, 0); vdf[cb][1] = packb(vd, 1);
            }
            const LAS unsigned char* arow = base + R_AQ + r32 * KP + hi * 8;
#pragma unroll
            for (int cb = 0; cb < 2; ++cb)
#pragma unroll
                for (int cb2 = 0; cb2 <= cb; ++cb2)
#pragma unroll
                    for (int s2 = 0; s2 < 2; ++s2) aq[cb] = __builtin_amdgcn_mfma_f32_32x32x16_bf16(afrag(arow + cb * 32 * KP + (32 * cb2 + 16 * s2) * 2), vbf[cb2][s2], aq[cb], 0, 0, 0);
            {   float* op = obuf + ((size_t)b * T_ + n * 64) * 512 + h * 128 + 32 * w + r32;
#pragma unroll
                for (int cb = 0; cb < 2; ++cb)
#pragma unroll
                    for (int r = 0; r < 16; ++r) { const int c = 32 * cb + (r & 3) + 8 * (r >> 2) + 4 * hi; op[(size_t)c * 512] = aq[cb][r]; } }
            const float el = egl[bh * 32 + n];
            const LAS unsigned char* krow = base + R_KT + r32 * KP + hi * 8;
#pragma unroll
            for (int rb = 0; rb < 4; ++rb) {
#pragma unroll
                for (int r = 0; r < 16; ++r) S[rb][r] *= el;
#pragma unroll
                for (int cb = 0; cb < 2; ++cb)
#pragma unroll
                    for (int s2 = 0; s2 < 2; ++s2) S[rb] = __builtin_amdgcn_mfma_f32_32x32x16_bf16(afrag(krow + rb * 32 * KP + (32 * cb + 16 * s2) * 2), vdf[cb][s2], S[rb], 0, 0, 0); }
        }
        if (n + 1 < 32) { REC_STORE(bf ^ 1);
#pragma unroll
            for (int i = 0; i < 8; ++i) uc[i] = ur[i]; }
        __syncthreads();
    }
#undef REC_LOAD
#undef REC_ST16
#undef REC_STORE
}
}

constexpr int NPHASES = 28;
__global__ void __launch_bounds__(NWAVES * 64, 2) mk_fwd(Args args) {
    extern __shared__ __attribute__((aligned(16))) unsigned char lds_raw[];
    LAS unsigned char* lds = (LAS unsigned char*)lds_raw;
    volatile LAS unsigned* MISC = (volatile LAS unsigned*)(lds + MISC_OFF);
#define tid ((int)threadIdx.x)
#define lane ((int)(threadIdx.x & 63))
#define wave (__builtin_amdgcn_readfirstlane((int)(threadIdx.x >> 6)))
#define G ((int)gridDim.x)
#define bid ((int)blockIdx.x)
#define gw (bid * NWAVES + wave)
#define NGW (G * NWAVES)
#define gt (bid * (NWAVES * 64) + tid)
#define NGT (G * NWAVES * 64)
    gu32* ctl = (gu32*)(args.ws + WS_CTL);
    for (int u = tid; u < (LDS_BYTES - LDSCTL_OFF) / 4; u += NWAVES * 64) ((LAS unsigned*)(lds + LDSCTL_OFF))[u] = 0u;
    __syncthreads();
    XcdBarrier bar = xcd_barrier_post((unsigned*)(ctl + CW_BAR) + args.li * XCD_BAR_WORDS, MISC + 8);
    const int lo = args.ph_lo, hi = args.ph_hi;
#ifndef PHMASK
#define PHMASK 0xfffffffu
#endif
#define IN(k) (((PHMASK >> (k)) & 1u) && lo <= (k) && (k) < hi)
#define SEAM(k) do { if (IN(k) && IN((k) + 1)) xcd_barrier(bar); } while (0)
#define Q_ws (args.ws)
#define Q_x ((const float*)args.in[0])
#define Q_mem ((const float*)args.in[1])
#define Q_pos ((const int*)args.in[2])
#define Q_gains ((const float*)args.in[3])
#define Q_mem_norm ((const float*)args.in[4])
#define Q_e_o_norm ((const float*)args.in[9])
#define Q_o_conv_w ((const float*)args.in[16])
#define Q_o_conv_b ((const float*)args.in[17])
#define Q_o_gate_a_b ((const float*)args.in[19])
#define Q_o_gate_x_b ((const float*)args.in[21])
#define Q_o_a_param ((const float*)args.in[22])
#define Q_out (args.out)
#define Q_WT ((bf16_t*)(Q_ws + WS_WT))
#define Q_kvmem ((bf16_t*)(Q_ws + WS_KVMEM))
#define Q_memn ((bf16_t*)(Q_ws + WS_MEMN))
#define Q_ropec ((float*)(Q_ws + WS_ROPEC))
#define Q_ropes ((float*)(Q_ws + WS_ROPES))
#define Q_abuf ((float*)(Q_ws + WS_ABUF))
#define Q_ssq ((float*)(Q_ws + WS_SSQ))
#define Q_kpe ((bf16_t*)(Q_ws + WS_KPE))
#define Q_aggA ((float*)(Q_ws + WS_AGG))
#define Q_aggH (Q_aggA + B_ * 32 * 1024)
#define Q_hbuf ((bf16_t*)(Q_ws + WS_H))
#define Q_labuf ((bf16_t*)(Q_ws + WS_H))
#define Q_ybuf ((bf16_t*)(Q_ws + WS_Y))
#define Q_vbuf ((bf16_t*)(Q_ws + WS_Y))
#define Q_cqkv ((bf16_t*)(Q_ws + WS_Y + 16 * MiB))
#define Q_obuf ((float*)(Q_ws + WS_Y))
#define Q_xc ((bf16_t*)(Q_ws + WS_Y))
#define Q_qkbuf ((bf16_t*)(Q_ws + WS_QK))
#define Q_mixbuf Q_qkbuf
#define Q_qx Q_qkbuf
#define Q_xb Q_qkbuf
#define Q_abuf2 Q_qkbuf
#define Q_zbuf ((bf16_t*)(Q_ws + WS_Z))
#define Q_ox ((bf16_t*)(Q_ws + WS_Z))
#define Q_gatebuf ((bf16_t*)(Q_ws + WS_Z))
#define Q_fbuf ((bf16_t*)(Q_ws + WS_QK))
#define Q_ubuf ((bf16_t*)(Q_ws + WS_U))
#define Q_qh ((bf16_t*)(Q_ws + WS_G))
#define Q_kT ((bf16_t*)(Q_ws + WS_G + 16 * MiB))
#define Q_aqk ((bf16_t*)(Q_ws + WS_G + 32 * MiB))
#define Q_wbuf ((bf16_t*)(Q_ws + WS_H))
#define Q_uT ((bf16_t*)(Q_ws + WS_H + 16 * MiB))
#define Q_egc ((float*)(Q_ws + WS_EGC))
#define Q_edec ((float*)(Q_ws + WS_EDEC))
#define Q_egl ((float*)(Q_ws + WS_EGL))
#define Q_qmla ((bf16_t*)Q_out)
#define Q_knope ((bf16_t*)((unsigned char*)Q_out + 24 * MiB))
#define Q_vmla ((bf16_t*)((unsigned char*)Q_out + 40 * MiB))
#define WTP(off) ((const bf16_t*)((const unsigned char*)Q_WT + (off)))
#define GEMM_PHASE(EpiT, E, Aptr, lda_, Bptr, M__, N__, K__, div_, koff_, rot_) do { \
        int K_o = (K__), lda_o = (lda_); asm volatile("" : "+s"(K_o), "+s"(lda_o)); pg8::Gemm g_{(Aptr), (Bptr), (M__), (N__), K_o, lda_o, (div_), (koff_)}; pg8::StaticOrder S_; S_.init((M__), (N__), G, bid, (rot_)); \
        pg8::gemm_phase<EpiT, pg8::StaticOrder, true, true>(lds + RING_OFF, g_, S_, (E)); } while (0)

    if (IN(0)) {
        LAS float* scr = (LAS float*)(lds + RING_OFF + wave * 16384);
        for (int it = gw; it < args.nitems; it += NGW) {
            int j = 0;
#pragma unroll 1
            for (int q = 1; q < NJOBS; ++q) if (it >= args.jobs[q].first) j = q;
            const TJob& J = args.jobs[j];
            p0_tr_item(J.W, J.WT, J.ks, J.ldw, J.K, J.rows, J.mode, J.srcoff, it - J.first, scr, lane);
        }
        for (int m = gw; m < MM_; m += NGW) rms_row_to_bf16(Q_mem + (size_t)m * D_, Q_mem_norm, Q_memn + (size_t)m * D_, lane);
        for (int m = gw; m < M_; m += NGW) rms_row_to_bf16(Q_x + (size_t)m * D_, Q_gains, Q_hbuf + (size_t)m * D_, lane);
        for (int idx = gt; idx < M_ * 32; idx += NGT) { const int m = idx >> 5, i = idx & 31;
            const float inv = powf(10000.f, -(float)(2 * i) / 64.f); const float ang = (float)Q_pos[m] * inv; float s, c; sincosf(ang, &s, &c); Q_ropec[idx] = c; Q_ropes[idx] = s; }
    }
    SEAM(0);
    if (IN(1)) {
        pg8::EpiEin E{Q_ws};
        GEMM_PHASE(pg8::EpiEin, E, Q_hbuf, 1024, WTP(WT_EIN), M_, 2816, 1024, 0, 0, 0);
        pg8::EpiPlain E2{Q_kvmem, 2048, 0};
        GEMM_PHASE(pg8::EpiPlain, E2, Q_memn, 1024, WTP(WT_WKV), MM_, 2048, 1024, 0, 0, 192);
    }
    SEAM(1);
    if (IN(2)) {
        if (args.flags & FL_GDNPREP) {
            for (int ch = bid; ch < 1024; ch += G)
                gdn::prep_chunk(lds + RING_OFF, ch, Q_qkbuf, Q_vbuf, Q_abuf, (const float*)args.in[6], (const float*)args.in[7], (const float*)args.in[8],
                                Q_qh, Q_kT, Q_wbuf, Q_uT, Q_aqk, Q_egc, Q_edec, Q_egl);
        }
        pg8::EpiUq E{Q_qmla, Q_ssq, Q_ropec, Q_ropes};
        GEMM_PHASE(pg8::EpiUq, E, Q_cqkv, 512, WTP(WT_UQ), M_, 768, 256, 0, 0, 0);
        pg8::EpiUkv E2{Q_knope, Q_vmla, Q_ssq};
        GEMM_PHASE(pg8::EpiUkv, E2, Q_cqkv + 256, 512, WTP(WT_UKV), M_, 1024, 256, 0, 0, 0);
        pg8::EpiPlain E3{Q_kvmem + (size_t)2048 * 2048, 2048, 0};
        GEMM_PHASE(pg8::EpiPlain, E3, Q_memn, 1024, WTP(WT_WKV + (size_t)2048 * 1024 * 2), MM_, 2048, 1024, 0, 0, 192);
    }
    SEAM(2);
    if (IN(3)) {
        if (args.flags & FL_GDNREC) {
            const int vcu = (G % 8 == 0) ? (bid % 8) * (G / 8) + bid / 8 : bid;
            for (int j = (vcu + G - 128 % G) % G; j < 32; j += G) gdn::rec_unit(lds + RING_OFF, j, Q_qh, Q_kT, Q_wbuf, Q_uT, Q_aqk, Q_egc, Q_edec, Q_egl, Q_obuf);
        }
        if (args.flags & FL_MLA) {
            const int vcu = (G % 8 == 0) ? (bid % 8) * (G / 8) + bid / 8 : bid;
            for (int i = vcu; i < 128; i += G) { const int b = i >> 4, h = (i >> 2) & 3, j = i & 3;
#pragma unroll 1
                for (int e = 0; e < 2; ++e) { const int qb = e == 0 ? 7 - j : j; const size_t r0 = (size_t)b * T_ + qb * 256, k0 = (size_t)b * T_;
                    attn::Mla::unit(lds + RING_OFF, Q_qmla + r0 * 768 + h * 192, 768, Q_knope + k0 * 512 + h * 128, 512, 128, Q_kpe + k0 * 64, 64,
                                    Q_vmla + k0 * 512 + h * 128, 512, Q_mixbuf + r0 * 1024 + 512 + h * 128, 1024, 4 * qb + 4, qb * 256, 0.07216878364870322f * 1.4426950408889634f); } }
        }
    }
    SEAM(3);
    if (IN(4)) {
        for (int idx = gw; idx < M_ * 4; idx += NGW) { const int m = idx >> 2, h = idx & 3;
            const float2 o = *(const float2*)(Q_obuf + (size_t)m * 512 + h * 128 + lane * 2);
            const float r = rsqrtf(wave_sum(o.x * o.x + o.y * o.y) * (1.f / 128.f) + EPS);
            const unsigned zw = *(const unsigned*)(Q_zbuf + (size_t)m * 512 + h * 128 + lane * 2);
            const float z0 = __uint_as_float(zw << 16), z1 = __uint_as_float(zw & 0xffff0000u);
            const float2 gn = *(const float2*)(Q_e_o_norm + lane * 2);
            *(unsigned*)(Q_mixbuf + (size_t)m * 1024 + h * 128 + lane * 2) = pk2(o.x * r * gn.x * siluf_(z0), o.y * r * gn.y * siluf_(z1)); }
    }
    SEAM(4);
    if (IN(5)) { pg8::EpiPlain E{Q_ybuf, 1024, 0}; GEMM_PHASE(pg8::EpiPlain, E, Q_mixbuf, 1024, WTP(WT_EOUT), M_, 1024, 1024, 0, 0, 0); }
    SEAM(5);
    if (IN(6)) { for (int m = gw; m < M_; m += NGW) rowwise_row(Q_ybuf + (size_t)m * D_, Q_x + (size_t)m * D_, Q_out + (size_t)m * D_, Q_gains + 1 * 1024, Q_gains + 2 * 1024, Q_hbuf + (size_t)m * D_, lane); }
    SEAM(6);
    {
        constexpr int pb = 7;

        if constexpr (0 == 1) {
            if (IN(14)) { pg8::EpiOin E{Q_xb, Q_gatebuf}; GEMM_PHASE(pg8::EpiOin, E, Q_hbuf, 1024, WTP(WT_OIN), M_, 2048, 1024, 0, 0, 0); }
            SEAM(14);
            if (IN(15)) {
                for (int idx = gt; idx < M_ * 128; idx += NGT) { const int cg = (idx & 127) * 8; const int m = idx >> 7, t = m & (T_ - 1);
                    float acc[8];
#pragma unroll
                    for (int e = 0; e < 8; ++e) acc[e] = Q_o_conv_b[cg + e];
#pragma unroll
                    for (int j = 0; j < 4; ++j) { if (t - 3 + j < 0) continue; const v4u w = *(const v4u*)(Q_xb + (size_t)(m - 3 + j) * 1024 + cg); const float* cw = Q_o_conv_w + j * 1024 + cg;
                        acc[0] += cw[0] * __uint_as_float(w.x << 16); acc[1] += cw[1] * __uint_as_float(w.x & 0xffff0000u); acc[2] += cw[2] * __uint_as_float(w.y << 16); acc[3] += cw[3] * __uint_as_float(w.y & 0xffff0000u);
                        acc[4] += cw[4] * __uint_as_float(w.z << 16); acc[5] += cw[5] * __uint_as_float(w.z & 0xffff0000u); acc[6] += cw[6] * __uint_as_float(w.w << 16); acc[7] += cw[7] * __uint_as_float(w.w & 0xffff0000u); }
                    v4u o; o.x = pk2(acc[0], acc[1]); o.y = pk2(acc[2], acc[3]); o.z = pk2(acc[4], acc[5]); o.w = pk2(acc[6], acc[7]);
                    *(v4u*)(Q_xc + (size_t)m * 1024 + cg) = o; }
            }
            SEAM(15);
            if (IN(16)) { pg8::EpiLru E{Q_labuf, Q_ubuf, Q_xc, Q_o_gate_a_b, Q_o_gate_x_b, Q_o_a_param}; GEMM_PHASE(pg8::EpiLru, E, Q_xc, 1024, WTP(WT_GATE), M_, 2048, 256, 2, 256, 0); }
            SEAM(16);
            if (IN(17)) {
                for (int idx = gt; idx < B_ * 32 * 1024; idx += NGT) { const int c = idx & 1023, ch = (idx >> 10) & 31, b = idx >> 15;
                    float sa = 0.f, hh = 0.f; const size_t r0 = (size_t)b * T_ + ch * 64;
#pragma unroll 8
                    for (int t = 0; t < 64; ++t) { const float lv = bf2f(Q_labuf[(r0 + t) * 1024 + c]); sa += lv; hh = __expf(lv) * hh + bf2f(Q_ubuf[(r0 + t) * 1024 + c]); }
                    Q_aggA[idx] = sa; Q_aggH[idx] = hh; }
            }
            SEAM(17);
            if (IN(18)) {
                for (int idx = gt; idx < B_ * 32 * 1024; idx += NGT) { const int c = idx & 1023, ch = (idx >> 10) & 31, b = idx >> 15;
                    float hh = 0.f;
                    for (int j = 0; j < ch; ++j) hh = __expf(Q_aggA[(b * 32 + j) * 1024 + c]) * hh + Q_aggH[(b * 32 + j) * 1024 + c];
                    const size_t r0 = (size_t)b * T_ + ch * 64;
#pragma unroll 8
                    for (int t = 0; t < 64; ++t) { const float lv = bf2f(Q_labuf[(r0 + t) * 1024 + c]); hh = __expf(lv) * hh + bf2f(Q_ubuf[(r0 + t) * 1024 + c]);
                        Q_abuf2[(r0 + t) * 1024 + c] = f2bf(hh * bf2f(Q_gatebuf[(r0 + t) * 1024 + c])); } }
            }
            SEAM(18);
            if (IN(19)) { pg8::EpiPlain E{Q_ybuf, 1024, 0}; GEMM_PHASE(pg8::EpiPlain, E, Q_abuf2, 1024, WTP(WT_OOUT), M_, 1024, 1024, 0, 0, 0); }
            SEAM(19);
            if (IN(20)) { for (int m = gw; m < M_; m += NGW) rowwise_row(Q_ybuf + (size_t)m * D_, Q_out + (size_t)m * D_, Q_out + (size_t)m * D_, (Q_gains + 0) + 1 * 1024, (Q_gains + 0) + 2 * 1024, Q_hbuf + (size_t)m * D_, lane); }
            SEAM(20);
        }
        if (IN(pb)) { pg8::EpiPlain E{Q_qx, 1024, 0}; GEMM_PHASE(pg8::EpiPlain, E, Q_hbuf, 1024, WTP(WT_WQ + (size_t)0 * 1024 * 1024 * 2), M_, 1024, 1024, 0, 0, 0); }
        SEAM(pb);
        if (IN(pb + 1)) {
            if (args.flags & FL_XATTN) {
                for (int i = bid; i < 512; i += G) { const int b = i >> 6, h = (i >> 4) & 3, qb = i & 15; const size_t r0 = (size_t)b * T_ + qb * 128;
                    const bf16_t* kv = Q_kvmem + (size_t)0 * 2048 * 2048 + (size_t)b * NMEM * 2048 + h * 256;
                    attn::Xat::unit(lds + RING_OFF, Q_qx + r0 * 1024 + h * 256, 1024, kv, 2048, 256, kv, 2048, kv + 1024, 2048, Q_ox + r0 * 1024 + h * 256, 1024, NMEM / 32, -1, 0.0625f * 1.4426950408889634f); }
            }
        }
        SEAM(pb + 1);
        if (IN(pb + 2)) { pg8::EpiPlain E{Q_ybuf, 1024, 0}; GEMM_PHASE(pg8::EpiPlain, E, Q_ox, 1024, WTP(WT_WO + (size_t)0 * 1024 * 1024 * 2), M_, 1024, 1024, 0, 0, 0); }
        SEAM(pb + 2);
        if (IN(pb + 3)) { for (int m = gw; m < M_; m += NGW) rowwise_row(Q_ybuf + (size_t)m * D_, Q_out + (size_t)m * D_, Q_out + (size_t)m * D_, (Q_gains + 0) + 3 * 1024, (Q_gains + 0) + 4 * 1024, Q_hbuf + (size_t)m * D_, lane); }
        SEAM(pb + 3);
        if (IN(pb + 4)) { pg8::EpiSwiglu E{Q_fbuf}; GEMM_PHASE(pg8::EpiSwiglu, E, Q_hbuf, 1024, WTP(WT_FIN + (size_t)0 * 5632 * 1024 * 2), M_, 5632, 1024, 0, 0, 0); }
        SEAM(pb + 4);
        if (IN(pb + 5)) { pg8::EpiPlain E{Q_ybuf, 1024, 0}; GEMM_PHASE(pg8::EpiPlain, E, Q_fbuf, DFF, WTP(WT_FOUT + (size_t)0 * 1024 * DFF * 2), M_, 1024, DFF, 0, 0, 0); }
        SEAM(pb + 5);
        if (IN(pb + 6)) { for (int m = gw; m < M_; m += NGW) rowwise_row(Q_ybuf + (size_t)m * D_, Q_out + (size_t)m * D_, Q_out + (size_t)m * D_, (Q_gains + 0) + 5 * 1024, Q_gains + 6 * 1024, Q_hbuf + (size_t)m * D_, lane); }
        SEAM(pb + 6);
    }
    {
        constexpr int pb = 21;

        if constexpr (1 == 1) {
            if (IN(14)) { pg8::EpiOin E{Q_xb, Q_gatebuf}; GEMM_PHASE(pg8::EpiOin, E, Q_hbuf, 1024, WTP(WT_OIN), M_, 2048, 1024, 0, 0, 0); }
            SEAM(14);
            if (IN(15)) {
                for (int idx = gt; idx < M_ * 128; idx += NGT) { const int cg = (idx & 127) * 8; const int m = idx >> 7, t = m & (T_ - 1);
                    float acc[8];
#pragma unroll
                    for (int e = 0; e < 8; ++e) acc[e] = Q_o_conv_b[cg + e];
#pragma unroll
                    for (int j = 0; j < 4; ++j) { if (t - 3 + j < 0) continue; const v4u w = *(const v4u*)(Q_xb + (size_t)(m - 3 + j) * 1024 + cg); const float* cw = Q_o_conv_w + j * 1024 + cg;
                        acc[0] += cw[0] * __uint_as_float(w.x << 16); acc[1] += cw[1] * __uint_as_float(w.x & 0xffff0000u); acc[2] += cw[2] * __uint_as_float(w.y << 16); acc[3] += cw[3] * __uint_as_float(w.y & 0xffff0000u);
                        acc[4] += cw[4] * __uint_as_float(w.z << 16); acc[5] += cw[5] * __uint_as_float(w.z & 0xffff0000u); acc[6] += cw[6] * __uint_as_float(w.w << 16); acc[7] += cw[7] * __uint_as_float(w.w & 0xffff0000u); }
                    v4u o; o.x = pk2(acc[0], acc[1]); o.y = pk2(acc[2], acc[3]); o.z = pk2(acc[4], acc[5]); o.w = pk2(acc[6], acc[7]);
                    *(v4u*)(Q_xc + (size_t)m * 1024 + cg) = o; }
            }
            SEAM(15);
            if (IN(16)) { pg8::EpiLru E{Q_labuf, Q_ubuf, Q_xc, Q_o_gate_a_b, Q_o_gate_x_b, Q_o_a_param}; GEMM_PHASE(pg8::EpiLru, E, Q_xc, 1024, WTP(WT_GATE), M_, 2048, 256, 2, 256, 0); }
            SEAM(16);
            if (IN(17)) {
                for (int idx = gt; idx < B_ * 32 * 1024; idx += NGT) { const int c = idx & 1023, ch = (idx >> 10) & 31, b = idx >> 15;
                    float sa = 0.f, hh = 0.f; const size_t r0 = (size_t)b * T_ + ch * 64;
#pragma unroll 8
                    for (int t = 0; t < 64; ++t) { const float lv = bf2f(Q_labuf[(r0 + t) * 1024 + c]); sa += lv; hh = __expf(lv) * hh + bf2f(Q_ubuf[(r0 + t) * 1024 + c]); }
                    Q_aggA[idx] = sa; Q_aggH[idx] = hh; }
            }
            SEAM(17);
            if (IN(18)) {
                for (int idx = gt; idx < B_ * 32 * 1024; idx += NGT) { const int c = idx & 1023, ch = (idx >> 10) & 31, b = idx >> 15;
                    float hh = 0.f;
                    for (int j = 0; j < ch; ++j) hh = __expf(Q_aggA[(b * 32 + j) * 1024 + c]) * hh + Q_aggH[(b * 32 + j) * 1024 + c];
                    const size_t r0 = (size_t)b * T_ + ch * 64;
#pragma unroll 8
                    for (int t = 0; t < 64; ++t) { const float lv = bf2f(Q_labuf[(r0 + t) * 1024 + c]); hh = __expf(lv) * hh + bf2f(Q_ubuf[(r0 + t) * 1024 + c]);
                        Q_abuf2[(r0 + t) * 1024 + c] = f2bf(hh * bf2f(Q_gatebuf[(r0 + t) * 1024 + c])); } }
            }
            SEAM(18);
            if (IN(19)) { pg8::EpiPlain E{Q_ybuf, 1024, 0}; GEMM_PHASE(pg8::EpiPlain, E, Q_abuf2, 1024, WTP(WT_OOUT), M_, 1024, 1024, 0, 0, 0); }
            SEAM(19);
            if (IN(20)) { for (int m = gw; m < M_; m += NGW) rowwise_row(Q_ybuf + (size_t)m * D_, Q_out + (size_t)m * D_, Q_out + (size_t)m * D_, (Q_gains + 6144) + 1 * 1024, (Q_gains + 6144) + 2 * 1024, Q_hbuf + (size_t)m * D_, lane); }
            SEAM(20);
        }
        if (IN(pb)) { pg8::EpiPlain E{Q_qx, 1024, 0}; GEMM_PHASE(pg8::EpiPlain, E, Q_hbuf, 1024, WTP(WT_WQ + (size_t)1 * 1024 * 1024 * 2), M_, 1024, 1024, 0, 0, 0); }
        SEAM(pb);
        if (IN(pb + 1)) {
            if (args.flags & FL_XATTN) {
                for (int i = bid; i < 512; i += G) { const int b = i >> 6, h = (i >> 4) & 3, qb = i & 15; const size_t r0 = (size_t)b * T_ + qb * 128;
                    const bf16_t* kv = Q_kvmem + (size_t)1 * 2048 * 2048 + (size_t)b * NMEM * 2048 + h * 256;
                    attn::Xat::unit(lds + RING_OFF, Q_qx + r0 * 1024 + h * 256, 1024, kv, 2048, 256, kv, 2048, kv + 1024, 2048, Q_ox + r0 * 1024 + h * 256, 1024, NMEM / 32, -1, 0.0625f * 1.4426950408889634f); }
            }
        }
        SEAM(pb + 1);
        if (IN(pb + 2)) { pg8::EpiPlain E{Q_ybuf, 1024, 0}; GEMM_PHASE(pg8::EpiPlain, E, Q_ox, 1024, WTP(WT_WO + (size_t)1 * 1024 * 1024 * 2), M_, 1024, 1024, 0, 0, 0); }
        SEAM(pb + 2);
        if (IN(pb + 3)) { for (int m = gw; m < M_; m += NGW) rowwise_row(Q_ybuf + (size_t)m * D_, Q_out + (size_t)m * D_, Q_out + (size_t)m * D_, (Q_gains + 6144) + 3 * 1024, (Q_gains + 6144) + 4 * 1024, Q_hbuf + (size_t)m * D_, lane); }
        SEAM(pb + 3);
        if (IN(pb + 4)) { pg8::EpiSwiglu E{Q_fbuf}; GEMM_PHASE(pg8::EpiSwiglu, E, Q_hbuf, 1024, WTP(WT_FIN + (size_t)1 * 5632 * 1024 * 2), M_, 5632, 1024, 0, 0, 0); }
        SEAM(pb + 4);
        if (IN(pb + 5)) { pg8::EpiPlain E{Q_ybuf, 1024, 0}; GEMM_PHASE(pg8::EpiPlain, E, Q_fbuf, DFF, WTP(WT_FOUT + (size_t)1 * 1024 * DFF * 2), M_, 1024, DFF, 0, 0, 0); }
        SEAM(pb + 5);
        if (IN(pb + 6)) { for (int m = gw; m < M_; m += NGW) rowwise_row(Q_ybuf + (size_t)m * D_, Q_out + (size_t)m * D_, Q_out + (size_t)m * D_, (Q_gains + 6144) + 5 * 1024, Q_gains + 6 * 1024, nullptr, lane); }
        SEAM(pb + 6);
    }
#undef IN
#undef SEAM
}
#undef tid
#undef lane
#undef wave
#undef G
#undef bid
#undef gw
#undef NGW
#undef gt
#undef NGT
#undef Q_ws
#undef Q_x
#undef Q_mem
#undef Q_pos
#undef Q_gains
#undef Q_mem_norm
#undef Q_e_o_norm
#undef Q_o_conv_w
#undef Q_o_conv_b
#undef Q_o_gate_a_b
#undef Q_o_gate_x_b
#undef Q_o_a_param
#undef Q_out
#undef Q_WT
#undef Q_kvmem
#undef Q_memn
#undef Q_ropec
#undef Q_ropes
#undef Q_abuf
#undef Q_ssq
#undef Q_kpe
#undef Q_aggA
#undef Q_aggH
#undef Q_hbuf
#undef Q_labuf
#undef Q_ybuf
#undef Q_vbuf
#undef Q_cqkv
#undef Q_obuf
#undef Q_xc
#undef Q_qkbuf
#undef Q_mixbuf
#undef Q_qx
#undef Q_xb
#undef Q_abuf2
#undef Q_zbuf
#undef Q_ox
#undef Q_gatebuf
#undef Q_fbuf
#undef Q_ubuf
#undef Q_qh
#undef Q_kT
#undef Q_aqk
#undef Q_wbuf
#undef Q_uT
#undef Q_egc
#undef Q_edec
#undef Q_egl
#undef Q_qmla
#undef Q_knope
#undef Q_vmla
#undef WTP
#undef GEMM_PHASE

template <bool DUAL, class Epi>
static void gemm_n(hipStream_t st, const bf16_t* A, int lda, const float* W, const float* W2, int ldw, int M, int N, int K, const float* ks, Epi e) {
    dim3 g((N + 255) / 256, M / (DUAL ? 16 : 32));
    hipLaunchKernelGGL((nk_gemm<DUAL, Epi>), g, dim3(256), 0, st, A, lda, W, W2, ldw, N, K, ks, e);
}
static int g_grid = 0;
static void mk_launch(hipStream_t stream, Args& a, int lo, int hi, int& li) {
    a.ph_lo = lo; a.ph_hi = hi; a.li = li++;
    void* kargs[] = {&a};
    hipError_t e = hipLaunchCooperativeKernel((const void*)mk_fwd, dim3(g_grid), dim3(NWAVES * 64), kargs, LDS_BYTES, stream);
    if (e != hipSuccess) fprintf(stderr, "kernel_launch: cooperative launch [%d,%d) failed: %s (grid %d)\n", lo, hi, hipGetErrorString(e), g_grid);
}

extern "C" void kernel_launch(void* const* d_in, const int* in_sizes, int n_in, void* d_out, int out_size, void* d_ws, size_t ws_size, hipStream_t stream) {
    static int init = 0;
    if (!init) {
        init = 1;
        if (ws_size < WS_END) fprintf(stderr, "kernel_launch: workspace too small: %zu\n", ws_size);
        (void)hipFuncSetAttribute((const void*)nk_gdn_prep, hipFuncAttributeMaxDynamicSharedMemorySize, GDN_PREP_LDS);
        (void)hipFuncSetAttribute((const void*)nk_attn<128, 64, 128, 64>, hipFuncAttributeMaxDynamicSharedMemorySize, attn_lds<128, 64, 128, 64>());
        (void)hipFuncSetAttribute((const void*)nk_attn<256, 0, 256, 32>, hipFuncAttributeMaxDynamicSharedMemorySize, attn_lds<256, 0, 256, 32>());
        (void)hipFuncSetAttribute((const void*)mk_fwd, hipFuncAttributeMaxDynamicSharedMemorySize, LDS_BYTES);
        int dev = 0, cus = 0, per_cu = 0;
        (void)hipGetDevice(&dev); (void)hipDeviceGetAttribute(&cus, hipDeviceAttributeMultiprocessorCount, dev);
        (void)hipOccupancyMaxActiveBlocksPerMultiprocessor(&per_cu, (const void*)mk_fwd, NWAVES * 64, LDS_BYTES);
        if (per_cu < 1) { fprintf(stderr, "kernel_launch: occupancy query says %d blocks per CU\n", per_cu); per_cu = 1; }
        if (per_cu > 1) per_cu = 1;
        g_grid = cus * per_cu;
        (void)hipGetLastError();
    }
    const float* x = (const float*)d_in[0];
    const float* e_conv_w = (const float*)d_in[6]; const float* e_a_log = (const float*)d_in[7]; const float* e_dt_bias = (const float*)d_in[8];
    float* out = (float*)d_out; unsigned char* ws = (unsigned char*)d_ws;
    bf16_t* kvmem = (bf16_t*)(ws + WS_KVMEM);
    float* abuf = (float*)(ws + WS_ABUF); bf16_t* kpe = (bf16_t*)(ws + WS_KPE);
    float* egc = (float*)(ws + WS_EGC); float* edec = (float*)(ws + WS_EDEC); float* egl = (float*)(ws + WS_EGL);
    bf16_t* wbuf = (bf16_t*)(ws + WS_H); bf16_t* uT = (bf16_t*)(ws + WS_H + 16 * MiB);
    bf16_t* vbuf = (bf16_t*)(ws + WS_Y); float* obuf = (float*)(ws + WS_Y);
    bf16_t* qkbuf = (bf16_t*)(ws + WS_QK); bf16_t* mixbuf = qkbuf; bf16_t* qx = qkbuf;
    bf16_t* ox = (bf16_t*)(ws + WS_Z);
    bf16_t* qh = (bf16_t*)(ws + WS_G); bf16_t* kT = (bf16_t*)(ws + WS_G + 16 * MiB); bf16_t* aqk = (bf16_t*)(ws + WS_G + 32 * MiB);
    bf16_t* qmla = (bf16_t*)d_out; bf16_t* knope = (bf16_t*)((unsigned char*)d_out + 24 * MiB); bf16_t* vmla = (bf16_t*)((unsigned char*)d_out + 40 * MiB);

    Args a{};
    for (int i = 0; i < 29; ++i) a.in[i] = d_in[i];
    a.out = out; a.ws = ws;
    {
        int nj = 0, first = 0; unsigned char* wt = ws + WS_WT;
        auto add = [&](const void* W, size_t wtoff, const void* ks, int ldw, int K, int rows, int mode, int srcoff) {
            TJob& J = a.jobs[nj++]; J.W = (const float*)W; J.WT = (bf16_t*)(wt + wtoff); J.ks = (const float*)ks; J.ldw = ldw; J.K = K; J.rows = rows; J.mode = mode; J.srcoff = srcoff; J.first = first;
            first += (K / 64) * (rows / 32); };
        add(d_in[5], WT_EIN, nullptr, EIN, 1024, 2816, 1, 0);
        add(d_in[12], WT_UQ, d_in[10], 768, 256, 768, 3, 0);
        add(d_in[13], WT_UKV, d_in[11], 1024, 256, 1024, 0, 0);
        add(d_in[14], WT_EOUT, nullptr, 1024, 1024, 1024, 0, 0);
        add(d_in[15], WT_OIN, nullptr, 2048, 1024, 2048, 0, 0);
        for (int blk = 0; blk < 4; ++blk) for (int q = 0; q < 4; ++q)
            add((const float*)d_in[(q & 1) ? 20 : 18] + (size_t)blk * 65536, WT_GATE + (size_t)(blk * 512 + q * 128) * 256 * 2, nullptr, 256, 256, 128, 0, (q >> 1) * 128);
        add(d_in[23], WT_OOUT, nullptr, 1024, 1024, 1024, 0, 0);
        for (int l = 0; l < 2; ++l) add((const float*)d_in[24] + (size_t)l * 1024 * 1024, WT_WQ + (size_t)l * 1024 * 1024 * 2, nullptr, 1024, 1024, 1024, 0, 0);
        for (int l = 0; l < 2; ++l) add((const float*)d_in[25] + (size_t)l * 1024 * 2048, WT_WKV + (size_t)l * 2048 * 1024 * 2, nullptr, 2048, 1024, 2048, 0, 0);
        for (int l = 0; l < 2; ++l) add((const float*)d_in[26] + (size_t)l * 1024 * 1024, WT_WO + (size_t)l * 1024 * 1024 * 2, nullptr, 1024, 1024, 1024, 0, 0);
        for (int l = 0; l < 2; ++l) add((const float*)d_in[27] + (size_t)l * 1024 * 5632, WT_FIN + (size_t)l * 5632 * 1024 * 2, nullptr, 5632, 1024, 5632, 2, 0);
        for (int l = 0; l < 2; ++l) add((const float*)d_in[28] + (size_t)l * DFF * 1024, WT_FOUT + (size_t)l * 1024 * DFF * 2, nullptr, 1024, DFF, 1024, 0, 0);
        a.nitems = first;
        if (nj != NJOBS) fprintf(stderr, "kernel_launch: job count %d != %d\n", nj, NJOBS);
    }
    a.flags = FL_MLA | FL_XATTN | FL_GDNPREP | FL_GDNREC;
    (void)hipMemsetAsync(ws + WS_CTL, 0, CTL_ZERO_BYTES, stream);
    int li = 0;
    mk_launch(stream, a, 0, NPHASES, li);
}
```
